# Optimizing an MI355X kernel written in HIP

```python
import jax, jax.numpy as jnp
from jax import lax
import numpy as np

D_MODEL = 2048
BATCH = 2
SEQ = 8192
DEPTH = 2

MIX_WIDTH = D_MODEL
DN_HEADS = 8
DN_HEAD_DIM = (MIX_WIDTH // 2) // DN_HEADS
DN_WIDTH = DN_HEADS * DN_HEAD_DIM
CONV_K = 4
CHUNK = 64
AT_HEAD_DIM = 64
AT_Q_HEADS = (MIX_WIDTH - DN_WIDTH) // AT_HEAD_DIM
AT_KV_HEADS = 2
AT_WIDTH = AT_Q_HEADS * AT_HEAD_DIM
AT_KV_WIDTH = AT_KV_HEADS * AT_HEAD_DIM
WINDOW = 128
ROPE_THETA = 10000.0
COL_SIZES = (3 * DN_WIDTH, DN_WIDTH, DN_HEADS, DN_HEADS, AT_WIDTH, AT_KV_WIDTH, AT_KV_WIDTH)
IN_COLS = 3 * DN_WIDTH + DN_WIDTH + 2 * DN_HEADS + AT_WIDTH + 2 * AT_KV_WIDTH
FFN_DIM = ((8 * D_MODEL + 3 * 256 - 1) // (3 * 256)) * 256
N_MOD = 6
EPS = 1e-6

kernel_name = "hybrid_deltanet_swa_sink_adaln_block"


def rms_norm(x, gain):
    xf = x.astype(jnp.float32)
    y = xf * lax.rsqrt(jnp.mean(xf * xf, axis=-1, keepdims=True) + EPS)
    return (y * gain.astype(jnp.float32)).astype(x.dtype)


def l2_norm(x):
    return x * lax.rsqrt(jnp.sum(x * x, axis=-1, keepdims=True) + EPS)


def rope(x, pos):
    d = x.shape[-1]
    half = d // 2
    inv_freq = ROPE_THETA ** (-jnp.arange(half, dtype=jnp.float32) * 2.0 / d)
    ang = pos.astype(jnp.float32)[:, None] * inv_freq[None, :]
    cos = jnp.cos(ang)[None, :, None, :]
    sin = jnp.sin(ang)[None, :, None, :]
    xf = x.astype(jnp.float32)
    x1, x2 = xf[..., :half], xf[..., half:]
    return jnp.concatenate([x1 * cos - x2 * sin, x2 * cos + x1 * sin], axis=-1).astype(x.dtype)


def to_chunks(t):
    b, tl, h = t.shape[:3]
    t = t.reshape(b, tl // CHUNK, CHUNK, h, *t.shape[3:])
    return jnp.moveaxis(t, 3, 1)


def chunk_gated_delta_rule(q, k, v, g, beta):
    b, tl, h, dv = v.shape
    qc, kc, vc = to_chunks(q), to_chunks(k), to_chunks(v)
    gc = jnp.cumsum(to_chunks(g), axis=-1)
    bc = to_chunks(beta)[..., None]
    causal = jnp.tril(jnp.ones((CHUNK, CHUNK), dtype=bool))
    strict = jnp.tril(jnp.ones((CHUNK, CHUNK), dtype=bool), -1)
    decay = jnp.exp(jnp.where(causal, gc[..., :, None] - gc[..., None, :], -jnp.inf))
    kb = kc * bc
    vb = vc * bc
    eye = jnp.eye(CHUNK, dtype=jnp.float32)
    lower = jnp.where(strict, jnp.einsum('bhncd,bhnsd->bhncs', kb, kc) * decay, 0.0) + eye
    t_inv = lax.linalg.triangular_solve(lower, jnp.broadcast_to(eye, lower.shape),
                                        left_side=True, lower=True, unit_diagonal=True)
    w = jnp.einsum('bhncs,bhnsd->bhncd', t_inv, kb * jnp.exp(gc)[..., None])
    u = jnp.einsum('bhncs,bhnsd->bhncd', t_inv, vb)
    intra = jnp.where(causal, jnp.einsum('bhncd,bhnsd->bhncs', qc, kc) * decay, 0.0)
    qg = qc * jnp.exp(gc)[..., None]
    kd = kc * jnp.exp(gc[..., -1:] - gc)[..., None]
    glast = jnp.exp(gc[..., -1])

    def step(state, inp):
        w_i, u_i, qg_i, intra_i, kd_i, gl_i = inp
        v_new = u_i - jnp.einsum('bhck,bhkv->bhcv', w_i, state)
        o_i = jnp.einsum('bhck,bhkv->bhcv', qg_i, state) + jnp.einsum('bhcs,bhsv->bhcv', intra_i, v_new)
        state = state * gl_i[..., None, None] + jnp.einsum('bhck,bhcv->bhkv', kd_i, v_new)
        return state, o_i

    seq_first = lambda t: jnp.moveaxis(t, 2, 0)
    state0 = jnp.zeros((b, h, q.shape[-1], dv), jnp.float32)
    _, o = lax.scan(step, state0, (seq_first(w), seq_first(u), seq_first(qg), seq_first(intra),
                                   seq_first(kd), jnp.moveaxis(glast, 2, 0)))
    o = jnp.moveaxis(jnp.moveaxis(o, 0, 2), 1, 3)
    return o.reshape(b, tl, h, dv)


def gated_deltanet(qkv, z, b_raw, a_raw, conv_w, a_log, dt_bias, norm_w):
    bsz, tl, _ = qkv.shape
    conv = lax.conv_general_dilated(qkv, conv_w[:, None, :].astype(qkv.dtype), window_strides=(1,),
                                    padding=[(CONV_K - 1, 0)], dimension_numbers=('NWC', 'WIO', 'NWC'),
                                    feature_group_count=3 * DN_WIDTH)
    conv = jax.nn.silu(conv.astype(jnp.float32))
    q, k, v = jnp.split(conv, 3, axis=-1)
    shp = (bsz, tl, DN_HEADS, DN_HEAD_DIM)
    q = l2_norm(q.reshape(shp)) * (DN_HEAD_DIM ** -0.5)
    k = l2_norm(k.reshape(shp))
    v = v.reshape(shp)
    beta = jax.nn.sigmoid(b_raw.astype(jnp.float32))
    g = -jnp.exp(a_log.astype(jnp.float32)) * jax.nn.softplus(a_raw.astype(jnp.float32) + dt_bias.astype(jnp.float32))
    o = chunk_gated_delta_rule(q, k, v, g, beta)
    o = o * lax.rsqrt(jnp.mean(o * o, axis=-1, keepdims=True) + EPS) * norm_w.astype(jnp.float32)
    o = o * jax.nn.silu(z.astype(jnp.float32).reshape(shp))
    return o.reshape(bsz, tl, DN_WIDTH).astype(qkv.dtype)


def sliding_window_attention_sinks(q, k, v, sinks):
    bsz, tl, _, dh = q.shape
    nb = tl // WINDOW
    grp = AT_Q_HEADS // AT_KV_HEADS
    qb = q.reshape(bsz, nb, WINDOW, AT_KV_HEADS, grp, dh)
    def band(t):
        tb = t.reshape(bsz, nb, WINDOW, AT_KV_HEADS, dh)
        prev = jnp.pad(tb, ((0, 0), (1, 0), (0, 0), (0, 0), (0, 0)))[:, :-1]
        return jnp.concatenate([prev, tb], axis=2)
    kw, vw = band(k), band(v)
    s = jnp.einsum('bnqhgd,bnkhd->bnhgqk', qb, kw).astype(jnp.float32) * (dh ** -0.5)
    r = jnp.arange(WINDOW)[:, None]
    j = jnp.arange(2 * WINDOW)[None, :]
    in_band = (j > r) & (j <= r + WINDOW)
    valid = (jnp.arange(nb)[:, None, None] > 0) | (j >= WINDOW)[None]
    mask = (in_band[None] & valid)[None, :, None, None]
    s = jnp.where(mask, s, -jnp.inf)
    sink = sinks.astype(jnp.float32).reshape(AT_KV_HEADS, grp)[None, None, :, :, None, None]
    m = jnp.maximum(jnp.max(s, axis=-1, keepdims=True), sink)
    p = jnp.exp(s - m)
    p = p / (jnp.sum(p, axis=-1, keepdims=True) + jnp.exp(sink - m))
    o = jnp.einsum('bnhgqk,bnkhd->bnqhgd', p.astype(v.dtype), vw)
    return o.reshape(bsz, tl, AT_WIDTH)


def setup_inputs(seed: int = 0) -> dict:
    key = jax.random.key(seed)
    ks = jax.random.split(key, 20)
    f32 = jnp.float32
    nrm = lambda k, shp, s: jax.random.normal(k, shp, f32) * s
    return {
        "x": nrm(ks[0], (BATCH, SEQ, D_MODEL), 1.0),
        "c": nrm(ks[1], (BATCH, D_MODEL), 1.0),
        "ln_mix": 1.0 + nrm(ks[2], (DEPTH, D_MODEL), 0.02),
        "ln_ffn": 1.0 + nrm(ks[3], (DEPTH, D_MODEL), 0.02),
        "w_ada": nrm(ks[4], (DEPTH, D_MODEL, N_MOD * D_MODEL), D_MODEL ** -0.5),
        "b_ada": nrm(ks[5], (DEPTH, N_MOD * D_MODEL), 0.02),
        "w_in": nrm(ks[6], (DEPTH, D_MODEL, IN_COLS), D_MODEL ** -0.5),
        "dn_conv_w": nrm(ks[7], (DEPTH, CONV_K, 3 * DN_WIDTH), CONV_K ** -0.5),
        "dn_a_log": jnp.log(jax.random.uniform(ks[8], (DEPTH, DN_HEADS), f32, 1.0, 16.0)),
        "dn_dt_bias": jnp.log(jnp.expm1(jax.random.uniform(ks[9], (DEPTH, DN_HEADS), f32, 0.001, 0.1))),
        "dn_norm_w": 1.0 + nrm(ks[10], (DEPTH, DN_HEAD_DIM), 0.02),
        "attn_sinks": nrm(ks[11], (DEPTH, AT_Q_HEADS), 0.5),
        "w_out": nrm(ks[12], (DEPTH, MIX_WIDTH, D_MODEL), MIX_WIDTH ** -0.5),
        "w_gate_up": nrm(ks[13], (DEPTH, D_MODEL, 2 * FFN_DIM), D_MODEL ** -0.5),
        "w_down": nrm(ks[14], (DEPTH, FFN_DIM, D_MODEL), FFN_DIM ** -0.5),
        "ln_final": 1.0 + nrm(ks[15], (D_MODEL,), 0.02),
    }


def reference(x, c, ln_mix, ln_ffn, w_ada, b_ada, w_in, dn_conv_w, dn_a_log, dn_dt_bias,
              dn_norm_w, attn_sinks, w_out, w_gate_up, w_down, ln_final):
    bsz, tl, _ = x.shape
    pos = jnp.arange(tl, dtype=jnp.int32)
    split_at = np.cumsum(COL_SIZES)[:-1].tolist()
    c_act = jax.nn.silu(c)
    for l in range(DEPTH):
        mod = c_act @ w_ada[l] + b_ada[l]
        sh_m, sc_m, gt_m, sh_f, sc_f, gt_f = [t[:, None, :] for t in jnp.split(mod, N_MOD, axis=-1)]
        h = rms_norm(x, ln_mix[l]) * (1.0 + sc_m) + sh_m
        proj = h @ w_in[l]
        dn_qkv, dn_z, dn_b, dn_a, at_q, at_k, at_v = jnp.split(proj, split_at, axis=-1)
        dn_out = gated_deltanet(dn_qkv, dn_z, dn_b, dn_a, dn_conv_w[l], dn_a_log[l],
                                dn_dt_bias[l], dn_norm_w[l])
        q = rope(at_q.reshape(bsz, tl, AT_Q_HEADS, AT_HEAD_DIM), pos)
        k = rope(at_k.reshape(bsz, tl, AT_KV_HEADS, AT_HEAD_DIM), pos)
        v = at_v.reshape(bsz, tl, AT_KV_HEADS, AT_HEAD_DIM)
        at_out = sliding_window_attention_sinks(q, k, v, attn_sinks[l])
        mix = jnp.concatenate([dn_out, at_out], axis=-1) @ w_out[l]
        x = x + gt_m * mix
        h = rms_norm(x, ln_ffn[l]) * (1.0 + sc_f) + sh_f
        gate, up = jnp.split(h @ w_gate_up[l], 2, axis=-1)
        x = x + gt_f * ((jax.nn.silu(gate) * up) @ w_down[l])
    return rms_norm(x, ln_final)
```

```cpp
#include <hip/hip_runtime.h>
#include <hip/hip_cooperative_groups.h>
#include <cstdio>
#include <cstdint>
namespace cg = cooperative_groups;
#ifndef ONE_LAUNCH
#define ONE_LAUNCH 1
#endif
namespace pg8 {
#define PG8_LAS __attribute__((address_space(3)))
typedef unsigned short bf16_t;
typedef short bf16x8 __attribute__((ext_vector_type(8)));
typedef float f32x4 __attribute__((ext_vector_type(4)));
typedef unsigned u32x4 __attribute__((ext_vector_type(4)));
constexpr int BM = 256, BK = 64, HALF = 128, HTB = HALF * BK * 2  , STAGE_BYTES = 8 * HTB, NXCD = 8, WGM = 8;

__host__ __device__ __forceinline__ int lds_byte(int r, int c) { const int st = (r >> 4) * 2 + (c >> 5), rr = r & 15, cc = c & 31, ob = rr * 64 + cc * 2; return st * 1024 + (ob ^ (((ob >> 9) & 1) << 5)); }
__host__ __device__ __forceinline__ void stage_rc(int b, int& R, int& C) { const int st = b / 1024, sb = b % 1024, swz = sb ^ (((sb >> 9) & 1) << 5); R = (st >> 1) * 16 + swz / 64; C = (st & 1) * 32 + (swz % 64) / 2; }
__host__ __device__ __forceinline__ int perm32(int rho) { const int n = rho >> 4, i = rho & 15; return 8 * (i >> 2) + 4 * n + (i & 3); }

struct Unit { int pm, pn; };
struct Gemm { const bf16_t* A; const bf16_t* Bt; int M, N, K; };

struct StaticOrder {
    int nM, nN, nwg, G, c;
    __host__ __device__ void init(int M, int N, int G_, int c_) { nM = M / BM; nN = N / BM; nwg = nM * nN; G = G_; c = c_; }
    __host__ __device__ bool next(int i, Unit& u) const {
        const long L = (long)i * G + c; if (L >= nwg) return false;
        int wgid = (int)L; { const int q = nwg / NXCD, r = nwg % NXCD, xcd = wgid % NXCD, off = wgid / NXCD; wgid = (xcd < r ? xcd * (q + 1) : r * (q + 1) + (xcd - r) * q) + off; }
        const int nig = WGM * nN, gid = wgid / nig, fm = gid * WGM, gsz = (nM - fm) < WGM ? (nM - fm) : WGM;
        u.pm = fm + ((wgid % nig) % gsz); u.pn = (wgid % nig) / gsz; return true;
    }
    __device__ __forceinline__ void a_ready(const Unit&) const {}
    __device__ __forceinline__ void done(const Unit&) const {}
};

__device__ __forceinline__ unsigned cvt_pk_bf16(float lo, float hi) { unsigned r; asm volatile("v_cvt_pk_bf16_f32 %0, %1, %2" : "=v"(r) : "v"(lo), "v"(hi)); return r; }
template <class Epi, class Sched, bool ALIGN_EPI = false, bool SP2 = false>
__device__ __forceinline__ void gemm_phase(PG8_LAS unsigned char* lds, const Gemm g, const Sched& S, const Epi& E, const int tid_in) {
    const int tid = tid_in, wid = __builtin_amdgcn_readfirstlane(tid >> 6), lane = tid & 63, wr = wid >> 2, wc = wid & 3, fr = lane & 15, fq = lane >> 4;
    const int K = g.K, nt = K / BK;
    unsigned voffA[2], voffB[2];
#pragma unroll
    for (int i = 0; i < 2; ++i) { int R, C; stage_rc(tid * 16 + i * 8192, R, C); const int Rb = Epi::PERM ? ((R & ~31) + perm32(R & 31)) : R;
        voffA[i] = (unsigned)(R * K + C) * 2u; voffB[i] = (unsigned)(Rb * K + C) * 2u; }
    const size_t kstep = (size_t)(BK * 2);
    const size_t hstep = (size_t)HALF * K * 2;
    const size_t tstep = 2 * hstep;
    const unsigned ldsw = (unsigned)wid * 1024u;
    const int aoff = lds_byte(wr * 64 + fr, fq * 8), boff = lds_byte(wc * 32 + fr, fq * 8);
#define PG8_SA(b, h) (((b) * 2 + (h)) * HTB)
#define PG8_SB(b, h) ((4 + (b) * 2 + (h)) * HTB)
#define PG8_STAGE(bufoff, gbase, voff) do { _Pragma("unroll") for (int _i = 0; _i < 2; ++_i) \
        __builtin_amdgcn_global_load_lds((const unsigned*)((const char*)(gbase) + (voff)[_i]), (PG8_LAS unsigned*)(lds + (bufoff) + ldsw + _i * 8192), 16, 0, 0); } while (0)
#define PG8_LDA(dst, b, h) do { _Pragma("unroll") for (int m = 0; m < 4; ++m) _Pragma("unroll") for (int k = 0; k < 2; ++k) dst[m][k] = *(const PG8_LAS bf16x8*)(lds + PG8_SA(b, h) + aoff + m * 2048 + k * 1024); } while (0)
#define PG8_LDB(dst, b, h) do { _Pragma("unroll") for (int n = 0; n < 2; ++n) _Pragma("unroll") for (int k = 0; k < 2; ++k) dst[n][k] = *(const PG8_LAS bf16x8*)(lds + PG8_SB(b, h) + boff + n * 2048 + k * 1024); } while (0)
#define PG8_MMA(ai, bj, At, Bt) do { __builtin_amdgcn_s_setprio(1); _Pragma("unroll") for (int m = 0; m < 4; ++m) _Pragma("unroll") for (int n = 0; n < 2; ++n) _Pragma("unroll") for (int k = 0; k < 2; ++k) \
        acc[ai][bj][m][n] = __builtin_amdgcn_mfma_f32_16x16x32_bf16(Bt[n][k], At[m][k], acc[ai][bj][m][n], 0, 0, 0); __builtin_amdgcn_s_setprio(0); } while (0)
#define PG8_WAIT_V(n) asm volatile("s_waitcnt vmcnt(" #n ")" ::: "memory")
#define PG8_WAIT_L(n) asm volatile("s_waitcnt lgkmcnt(" #n ")" ::: "memory")
#define PG8_BAR __builtin_amdgcn_s_barrier()
#define PG8_SCHED __builtin_amdgcn_sched_barrier(0)
    Unit cur, nxt; int ui = 0;
    if (!S.next(0, cur)) return;
    f32x4 acc[2][2][4][2];
#pragma unroll
    for (int a = 0; a < 2; ++a)
#pragma unroll
        for (int b = 0; b < 2; ++b)
#pragma unroll
            for (int m = 0; m < 4; ++m)
#pragma unroll
                for (int n = 0; n < 2; ++n) acc[a][b][m][n] = (f32x4){0.f, 0.f, 0.f, 0.f};
    bf16x8 At[4][2], B0[2][2], B1[2][2];
    const char* cA = (const char*)g.A + (size_t)cur.pm * tstep; const char* cB = (const char*)g.Bt + (size_t)cur.pn * tstep;
    S.a_ready(cur);
    if constexpr (SP2) {
        PG8_STAGE(PG8_SB(0, 0), cB, voffB); PG8_STAGE(PG8_SB(0, 1), cB + hstep, voffB); PG8_STAGE(PG8_SA(0, 0), cA, voffA); PG8_STAGE(PG8_SA(0, 1), cA + hstep, voffA);
        if (wr == 1) PG8_BAR;
        PG8_WAIT_V(2); PG8_BAR;
        PG8_STAGE(PG8_SB(1, 0), cB + kstep, voffB); PG8_STAGE(PG8_SA(1, 0), cA + kstep, voffA); PG8_STAGE(PG8_SB(1, 1), cB + hstep + kstep, voffB);
        PG8_WAIT_V(6); PG8_BAR;
    } else {
        PG8_STAGE(PG8_SB(0, 0), cB, voffB); PG8_STAGE(PG8_SA(0, 0), cA, voffA); PG8_STAGE(PG8_SB(0, 1), cB + hstep, voffB); PG8_STAGE(PG8_SA(0, 1), cA + hstep, voffA);
        if (wr == 1) PG8_BAR;
        PG8_WAIT_V(4); PG8_BAR;
        PG8_STAGE(PG8_SB(1, 0), cB + kstep, voffB); PG8_STAGE(PG8_SA(1, 0), cA + kstep, voffA); PG8_STAGE(PG8_SB(1, 1), cB + hstep + kstep, voffB);
        PG8_WAIT_V(6); PG8_BAR;
    }
    for (;;) {
        const bool has_next = S.next(ui + 1, nxt);
        const char* nA = has_next ? (const char*)g.A + (size_t)nxt.pm * tstep : cA; const char* nB = has_next ? (const char*)g.Bt + (size_t)nxt.pn * tstep : cB;
        for (int t = 0; t < nt; t += 2) {
            const bool last = (t == nt - 2);
            const char* a1 = cA + (size_t)(t + 1) * kstep;
            const char* a2 = last ? nA : cA + (size_t)(t + 2) * kstep; const char* b2 = last ? nB : cB + (size_t)(t + 2) * kstep;
            const char* a3 = a2 + kstep; const char* b3 = b2 + kstep;
            if (last && has_next) S.a_ready(nxt);
            if constexpr (SP2) {
            PG8_LDB(B0, 0, 0); PG8_LDB(B1, 0, 1); PG8_SCHED; PG8_LDA(At, 0, 0); PG8_STAGE(PG8_SA(1, 1), a1 + hstep, voffA);
            PG8_WAIT_V(8); PG8_WAIT_L(0); PG8_BAR; PG8_MMA(0, 0, At, B0); PG8_MMA(0, 1, At, B1); PG8_BAR; PG8_SCHED;
            PG8_LDA(At, 0, 1); PG8_STAGE(PG8_SB(0, 0), b2, voffB); PG8_STAGE(PG8_SB(0, 1), b2 + hstep, voffB); PG8_STAGE(PG8_SA(0, 0), a2, voffA);
            PG8_WAIT_V(8); PG8_WAIT_L(0); PG8_BAR; PG8_MMA(1, 0, At, B0); PG8_MMA(1, 1, At, B1); PG8_BAR; PG8_SCHED;
            PG8_LDB(B0, 1, 0); PG8_LDB(B1, 1, 1); PG8_SCHED; PG8_LDA(At, 1, 0); PG8_STAGE(PG8_SA(0, 1), a2 + hstep, voffA);
            PG8_WAIT_V(8); PG8_WAIT_L(0); PG8_BAR; PG8_MMA(0, 0, At, B0); PG8_MMA(0, 1, At, B1); PG8_BAR; PG8_SCHED;
            PG8_LDA(At, 1, 1); PG8_STAGE(PG8_SB(1, 0), b3, voffB); PG8_STAGE(PG8_SB(1, 1), b3 + hstep, voffB); PG8_STAGE(PG8_SA(1, 0), a3, voffA);
            PG8_WAIT_V(8); PG8_WAIT_L(0); PG8_BAR; PG8_MMA(1, 0, At, B0); PG8_MMA(1, 1, At, B1); PG8_BAR; PG8_SCHED;
            } else {
            PG8_LDB(B0, 0, 0); PG8_SCHED; PG8_LDA(At, 0, 0); PG8_STAGE(PG8_SA(1, 1), a1 + hstep, voffA);
            PG8_WAIT_L(8); PG8_BAR; PG8_WAIT_L(0); PG8_MMA(0, 0, At, B0); PG8_BAR; PG8_SCHED;
            PG8_LDB(B1, 0, 1); PG8_STAGE(PG8_SB(0, 0), b2, voffB);
            PG8_BAR; PG8_WAIT_L(0); PG8_MMA(0, 1, At, B1); PG8_BAR;
            PG8_LDA(At, 0, 1); PG8_STAGE(PG8_SA(0, 0), a2, voffA);
            PG8_BAR; PG8_WAIT_L(0); PG8_MMA(1, 0, At, B0); PG8_BAR; PG8_SCHED;
            PG8_STAGE(PG8_SB(0, 1), b2 + hstep, voffB);
            PG8_WAIT_V(6); PG8_BAR; PG8_MMA(1, 1, At, B1); PG8_BAR;
            PG8_LDB(B0, 1, 0); PG8_SCHED; PG8_LDA(At, 1, 0); PG8_STAGE(PG8_SA(0, 1), a2 + hstep, voffA);
            PG8_WAIT_L(8); PG8_BAR; PG8_WAIT_L(0); PG8_MMA(0, 0, At, B0); PG8_BAR; PG8_SCHED;
            PG8_LDB(B1, 1, 1); PG8_STAGE(PG8_SB(1, 0), b3, voffB);
            PG8_BAR; PG8_WAIT_L(0); PG8_MMA(0, 1, At, B1); PG8_BAR;
            PG8_LDA(At, 1, 1); PG8_STAGE(PG8_SA(1, 0), a3, voffA);
            PG8_BAR; PG8_WAIT_L(0); PG8_MMA(1, 0, At, B0); PG8_BAR; PG8_SCHED;
            PG8_STAGE(PG8_SB(1, 1), b3 + hstep, voffB);
            PG8_WAIT_V(6); PG8_BAR; PG8_MMA(1, 1, At, B1); PG8_BAR;
            }
        }
        if constexpr (ALIGN_EPI) { if (wr == 0) PG8_BAR; }
        if constexpr (!Epi::AFTER_DRAIN) { E(acc, cur, wr, wc, fr, fq); S.done(cur); }
        if (!has_next) break;
#pragma unroll
        for (int a = 0; a < 2; ++a)
#pragma unroll
            for (int b = 0; b < 2; ++b)
#pragma unroll
                for (int m = 0; m < 4; ++m)
#pragma unroll
                    for (int n = 0; n < 2; ++n) acc[a][b][m][n] = (f32x4){0.f, 0.f, 0.f, 0.f};
        cur = nxt; cA = nA; cB = nB; ++ui;
        if constexpr (ALIGN_EPI) { if (wr == 1) PG8_BAR; }
    }
    PG8_WAIT_V(0);
    if constexpr (!ALIGN_EPI) { if (wr == 0) PG8_BAR; }
    PG8_BAR;
    if constexpr (Epi::AFTER_DRAIN) { E.fused(acc, cur, wr, wc, fr, fq, lds, wid, lane); S.done(cur); }
#undef PG8_SA
#undef PG8_SB
#undef PG8_STAGE
#undef PG8_LDA
#undef PG8_LDB
#undef PG8_MMA
#undef PG8_WAIT_V
#undef PG8_WAIT_L
#undef PG8_BAR
#undef PG8_SCHED
}
}

namespace mk {
#define LAS __attribute__((address_space(3)))
#define DI __device__ __forceinline__
typedef unsigned short bf16_t;
typedef short bf16x8 __attribute__((ext_vector_type(8)));
typedef float f32x4 __attribute__((ext_vector_type(4)));
typedef float f32x2 __attribute__((ext_vector_type(2)));
typedef float f32x16 __attribute__((ext_vector_type(16)));
typedef unsigned u32x4 __attribute__((ext_vector_type(4)));
typedef unsigned u32x2 __attribute__((ext_vector_type(2)));
typedef __bf16 bf16x2_t __attribute__((ext_vector_type(2)));
#define MFMA32(a, b, c) __builtin_amdgcn_mfma_f32_32x32x16_bf16((a), (b), (c), 0, 0, 0)

constexpr int T = 8192, M = 16384, D = 2048, DEPTH = 2;
constexpr int NPROJ = 5632, FF = 5632, NGU = 11264, INC = 5392, NMOD = 12288;
constexpr int C_Z = 3072, C_Q = 4096, C_K = 5120, C_V = 5248, C_BA = 5376;
constexpr float EPS = 1e-6f;
constexpr size_t MiB = (size_t)1 << 20;
constexpr size_t WS_CTL = 0;
constexpr size_t WS_WIN = 1 * MiB;
constexpr size_t WS_WOUT = WS_WIN + 44 * MiB;
constexpr size_t WS_WGU = WS_WOUT + 16 * MiB;
constexpr size_t WS_WDN = WS_WGU + 88 * MiB;
constexpr size_t WS_ACT = WS_WDN + 44 * MiB;
constexpr size_t WS_PROJ = WS_ACT + 64 * MiB;
constexpr size_t WS_QN = WS_PROJ + 176 * MiB;
constexpr size_t WS_KN = WS_QN + 32 * MiB;
constexpr size_t WS_VN = WS_KN + 32 * MiB;
constexpr size_t WS_ODN = WS_QN;
constexpr size_t WS_NW = WS_VN + 32 * MiB;
constexpr size_t WS_QG = WS_NW + 32 * MiB;
constexpr size_t WS_KD = WS_QG + 32 * MiB;
constexpr size_t WS_UF = WS_KD + 32 * MiB;
constexpr size_t WS_IN = WS_UF + 32 * MiB;
constexpr size_t WS_BA = WS_IN + 16 * MiB;
constexpr size_t WS_MODP = WS_BA + 1 * MiB;
constexpr size_t WS_MOD = WS_MODP + 3 * MiB;
constexpr size_t WS_ROPE = WS_MOD + 1 * MiB;
constexpr size_t WS_GL = WS_ROPE + 2 * MiB;
constexpr size_t WS_XR = WS_GL + 1 * MiB;
constexpr size_t WS_END = WS_XR + 64 * MiB;
static_assert(WS_END <= 768 * MiB, "d_ws map");

constexpr int LDS_BYTES = 155648;
constexpr int D3_SLOT = 61440;

struct Params {
    const float *x, *c, *ln_mix, *ln_ffn, *w_ada, *b_ada, *w_in, *conv_w, *a_log, *dt_bias, *norm_w, *sinks, *w_out, *w_gu, *w_dn, *ln_final;
    float* out; unsigned char* ws; int ph_lo, ph_hi;
};

DI unsigned cvtpk(float lo, float hi) { f32x2 v = {lo, hi}; bf16x2_t b = __builtin_convertvector(v, bf16x2_t); return __builtin_bit_cast(unsigned, b); }
DI void fnma_(float& a, float n, float w) { asm("v_fma_f32 %0, -%1, %2, %0" : "+v"(a) : "v"(n), "v"(w)); }
DI void fma_(float& a, float n, float w) { asm("v_fma_f32 %0, %1, %2, %0" : "+v"(a) : "v"(n), "v"(w)); }
DI unsigned bf1(float x) { return cvtpk(x, 0.f) & 0xffffu; }
DI float bflo(unsigned u) { return __uint_as_float(u << 16); }
DI float bfhi(unsigned u) { return __uint_as_float(u & 0xffff0000u); }
DI float wave_sum(float v) {
#pragma unroll
    for (int o = 1; o < 64; o <<= 1) v += __shfl_xor(v, o);
    return v;
}
DI float silu(float x) { return x * __builtin_amdgcn_rcpf(1.f + __expf(-x)); }
DI int crow(int i, int hi) { return (i & 3) + 8 * (i >> 2) + 4 * hi; }
DI int krow(int hi, int e) { return 8 * (e >> 2) + 4 * hi + (e & 3); }
DI int swap23(int p) { return (p & ~12) | ((p & 4) << 1) | ((p & 8) >> 1); }
DI void wave_lds_fence() { __builtin_amdgcn_fence(__ATOMIC_RELEASE, "wavefront"); __builtin_amdgcn_wave_barrier(); __builtin_amdgcn_fence(__ATOMIC_ACQUIRE, "wavefront"); }

DI int map_in(int c) {
    if (c < 4096) return c;
    if (c < 4112) return C_BA + (c - 4096);
    const int cp = c - 16;
    if (cp < C_V) { const int d = cp & 63, base = cp & ~63; return base + ((d < 32) ? 2 * d : 2 * (d - 32) + 1); }
    return cp;
}
DI int map_gu(int c) { const int up = c >= FF ? 1 : 0; const int j = up ? c - FF : c; return 256 * (j >> 7) + 128 * up + (j & 127); }
template <int MODE> DI void transpose_item(const float* __restrict__ W, int K, int N, bf16_t* WT, LAS float* scr, int item, int lane) {
    const int nblk = (N + 31) / 32, kb = item / nblk, nb = item % nblk, k0 = 64 * kb, n0 = 32 * nb;
    const int ncol = n0 + (lane & 31); const bool okc = ncol < N;
    float tv[32];
#pragma unroll
    for (int i = 0; i < 32; ++i) { const int kk = 2 * i + (lane >> 5); tv[i] = okc ? W[(size_t)(k0 + kk) * N + ncol] : 0.f; }
#pragma unroll
    for (int i = 0; i < 32; ++i) { const int kk = 2 * i + (lane >> 5); scr[kk * 33 + (lane & 31)] = tv[i]; }
    wave_lds_fence();
    const int c = lane & 7;
#pragma unroll
    for (int j = 0; j < 4; ++j) { const int n = (lane >> 3) + 8 * j; const LAS float* s = scr + (8 * c) * 33 + n;
        u32x4 o; o.x = cvtpk(s[0 * 33], s[1 * 33]); o.y = cvtpk(s[2 * 33], s[3 * 33]); o.z = cvtpk(s[4 * 33], s[5 * 33]); o.w = cvtpk(s[6 * 33], s[7 * 33]);
        const int nsrc = n0 + n;
        if (nsrc < N) { const int nd = MODE == 1 ? map_in(nsrc) : (MODE == 2 ? map_gu(nsrc) : nsrc); *(u32x4*)(WT + (size_t)nd * K + k0 + 8 * c) = o; } }
    wave_lds_fence();
}

constexpr int I_IN = 32 * 169, I_OUT = 32 * 64, I_GU = 32 * 352, I_DN = 88 * 64, I_L = I_IN + I_OUT + I_GU + I_DN;
DI void convert_items(const Params& P, LAS unsigned char* lds, int it0, int it1, int gw, int NGW, int wave, int lane) {
    LAS float* scr = (LAS float*)(lds + wave * 16384);
    bf16_t* WIN = (bf16_t*)(P.ws + WS_WIN); bf16_t* WOUT = (bf16_t*)(P.ws + WS_WOUT); bf16_t* WGU = (bf16_t*)(P.ws + WS_WGU); bf16_t* WDN = (bf16_t*)(P.ws + WS_WDN);
    for (int it = it0 + gw; it < it1; it += NGW) {
        const int l = it / I_L; int r = it % I_L;
        if (r < I_IN) { transpose_item<1>(P.w_in + (size_t)l * D * INC, D, INC, WIN + (size_t)l * NPROJ * D, scr, r, lane); continue; } r -= I_IN;
        if (r < I_OUT) { transpose_item<0>(P.w_out + (size_t)l * D * D, D, D, WOUT + (size_t)l * D * D, scr, r, lane); continue; } r -= I_OUT;
        if (r < I_GU) { transpose_item<2>(P.w_gu + (size_t)l * D * NGU, D, NGU, WGU + (size_t)l * NGU * D, scr, r, lane); continue; } r -= I_GU;
        transpose_item<0>(P.w_dn + (size_t)l * FF * D, FF, D, WDN + (size_t)l * D * FF, scr, r, lane);
    }
}
DI void p0_phase(const Params& P, LAS unsigned char* lds, int gw, int NGW, int wave, int lane) {
    bf16_t* WIN = (bf16_t*)(P.ws + WS_WIN);
    convert_items(P, lds, 0, I_IN, gw, NGW, wave, lane);
    const int gt = gw * 64 + lane, NGT = NGW * 64;
    for (int i = gt; i < 2 * 240 * 256; i += NGT) { const int l = i / (240 * 256), q = i % (240 * 256);
        *(u32x4*)(WIN + (size_t)l * NPROJ * D + (size_t)INC * D + (size_t)q * 8) = (u32x4){0u, 0u, 0u, 0u}; }
    float* ROPE = (float*)(P.ws + WS_ROPE);
    for (int i = gt; i < T * 32; i += NGT) { const int t = i >> 5, fi = i & 31;
        double f = 1.0; for (int q = 0; q < fi; ++q) f *= 0.7498942093324558;
        const float ang_f = (float)t * (float)f;
        const double ang = (double)ang_f, n = rint(ang * 0.15915494309189535), rr = (ang - n * 6.2831853071795862) - n * 2.4492935982947064e-16, r2 = rr * rr;
        double cs = 1.0, sn = rr, tc = 1.0, ts = rr;
#pragma unroll
        for (int q = 1; q <= 14; ++q) { tc *= -r2 * (1.0 / (double)((2 * q - 1) * (2 * q))); ts *= -r2 * (1.0 / (double)((2 * q) * (2 * q + 1))); cs += tc; sn += ts; }
        *(f32x2*)(ROPE + 2 * (size_t)i) = (f32x2){(float)cs, (float)sn}; }
    float* MODP = (float*)(P.ws + WS_MODP);
    for (int it = gw; it < 2 * 16 * 48; it += NGW) {
        const int cgp = it % 48, kc = (it / 48) % 16, l = it / 768, j0 = cgp * 256 + 4 * lane;
        f32x4 a0 = {0.f, 0.f, 0.f, 0.f}, a1 = {0.f, 0.f, 0.f, 0.f};
        const float* wp = P.w_ada + ((size_t)l * D + kc * 128) * NMOD + j0;
#pragma unroll 8
        for (int k = 0; k < 128; ++k) { const f32x4 w4 = *(const f32x4*)(wp + (size_t)k * NMOD);
            const float c0 = silu(P.c[kc * 128 + k]), c1 = silu(P.c[D + kc * 128 + k]); a0 += w4 * c0; a1 += w4 * c1; }
        *(f32x4*)(MODP + ((size_t)(kc * 2 + l) * 2 + 0) * NMOD + j0) = a0;
        *(f32x4*)(MODP + ((size_t)(kc * 2 + l) * 2 + 1) * NMOD + j0) = a1;
    }
}
DI void mod_phase(const Params& P, int gw, int NGW, int lane) {
    const float* MODP = (const float*)(P.ws + WS_MODP); float* MOD = (float*)(P.ws + WS_MOD);
    for (int i = gw * 64 + lane; i < 2 * 2 * NMOD; i += NGW * 64) { const int l = i / (2 * NMOD), j = i % NMOD;
        float s = P.b_ada[l * NMOD + j];
#pragma unroll
        for (int kc = 0; kc < 16; ++kc) s += MODP[(size_t)kc * (4 * NMOD) + i];
        MOD[i] = s; }
}

template <int MODE, bool XBF> DI void norm_phase(const void* Xv, const bf16_t* Y, bf16_t* xr_out, float* xout, const float* __restrict__ lnw, const float* __restrict__ modl  , int sh_off, int sc_off, bf16_t* out_bf, int gw, int NGW, int lane) {
    typedef __attribute__((address_space(1))) const f32x4* gcp; typedef __attribute__((address_space(1))) const u32x2* gcy;
    const int rows_per = (M + NGW - 1) / NGW; const int m0 = gw * rows_per, m1 = (m0 + rows_per < M) ? m0 + rows_per : M;
    if (m0 >= m1) return;
    f32x4 A[8], B[8]; int curb = -1;
    f32x4 v[8], vn[8]; u32x2 yv[8], yn[8], xb[8], xbn[8];
#define NP_LOAD(V, XB, YV, ROW) do { _Pragma("unroll") for (int j = 0; j < 8; ++j) { \
        if (XBF) XB[j] = ((gcy)((const bf16_t*)Xv + (size_t)(ROW) * D) + lane)[64 * j]; else V[j] = ((gcp)((const float*)Xv + (size_t)(ROW) * D) + lane)[64 * j]; \
        if (Y) YV[j] = ((gcy)(Y + (size_t)(ROW) * D) + lane)[64 * j]; } } while (0)
#pragma unroll
    for (int j = 0; j < 8; ++j) { v[j] = (f32x4){0.f, 0.f, 0.f, 0.f}; vn[j] = v[j]; yv[j] = (u32x2){0u, 0u}; yn[j] = yv[j]; xb[j] = yv[j]; xbn[j] = yv[j]; }
    NP_LOAD(v, xb, yv, m0);
    for (int m = m0; m < m1; ++m) {
        const int b = m / T;
        if (b != curb) { curb = b;
#pragma unroll
            for (int j = 0; j < 8; ++j) { const int k = 4 * (lane + 64 * j); const f32x4 g = *(const f32x4*)(lnw + k);
                if (MODE == 0) { const f32x4 sc = *(const f32x4*)(modl + b * NMOD + sc_off + k); A[j] = g * (sc + 1.0f); B[j] = *(const f32x4*)(modl + b * NMOD + sh_off + k); } else { A[j] = g; B[j] = (f32x4){0.f, 0.f, 0.f, 0.f}; } } }
        if (m + 1 < m1) NP_LOAD(vn, xbn, yn, m + 1);
        float s = 0.f;
#pragma unroll
        for (int j = 0; j < 8; ++j) { if (XBF) v[j] = (f32x4){bflo(xb[j].x), bfhi(xb[j].x), bflo(xb[j].y), bfhi(xb[j].y)};
            if (Y) { v[j].x += bflo(yv[j].x); v[j].y += bfhi(yv[j].x); v[j].z += bflo(yv[j].y); v[j].w += bfhi(yv[j].y); }
            s += (v[j].x * v[j].x + v[j].y * v[j].y) + (v[j].z * v[j].z + v[j].w * v[j].w); }
        const float rstd = 1.0f / sqrtf(wave_sum(s) * (1.0f / D) + EPS);
        if (MODE == 0) {
            if (xr_out) { u32x2* xo = (u32x2*)(xr_out + (size_t)m * D) + lane;
#pragma unroll
                for (int j = 0; j < 8; ++j) { u32x2 w; w.x = cvtpk(v[j].x, v[j].y); w.y = cvtpk(v[j].z, v[j].w); xo[64 * j] = w; } }
            u32x2* o = (u32x2*)(out_bf + (size_t)m * D) + lane;
#pragma unroll
            for (int j = 0; j < 8; ++j) { const f32x4 y = v[j] * rstd * A[j] + B[j]; u32x2 w; w.x = cvtpk(y.x, y.y); w.y = cvtpk(y.z, y.w); o[64 * j] = w; }
        } else { f32x4* xo = (f32x4*)(xout + (size_t)m * D) + lane;
#pragma unroll
            for (int j = 0; j < 8; ++j) xo[64 * j] = v[j] * rstd * A[j]; }
#pragma unroll
        for (int j = 0; j < 8; ++j) { v[j] = vn[j]; yv[j] = yn[j]; xb[j] = xbn[j]; }
    }
#undef NP_LOAD
}

struct EpiIn {
    static constexpr bool PERM = true, AFTER_DRAIN = false;
    bf16_t* O; float* BA; const float* rope;
    DI void operator()(const pg8::f32x4 (&acc)[2][2][4][2], const pg8::Unit& u, int wr, int wc, int fr, int fq) const {
        const int row0 = u.pm * 256 + wr * 64 + fr, col0 = u.pn * 256 + wc * 32 + 8 * fq;
        typedef __attribute__((address_space(1))) const f32x4* gcp;
        const bool any_rope = (u.pn >= 16 && u.pn <= 20);
#pragma unroll
        for (int ai = 0; ai < 2; ++ai) {
            f32x4 rp[4][2][2];
            if (any_rope) {
#pragma unroll
                for (int m = 0; m < 4; ++m) { const int t = (row0 + ai * 128 + m * 16) & (T - 1);
#pragma unroll
                    for (int bj = 0; bj < 2; ++bj) { const int i0 = ((col0 + bj * 128) & 63) >> 1;
                        rp[m][bj][0] = *(gcp)(rope + ((size_t)t * 32 + i0) * 2); rp[m][bj][1] = *(gcp)(rope + ((size_t)t * 32 + i0 + 2) * 2); } } }
#pragma unroll
            for (int m = 0; m < 4; ++m) { const int row = row0 + ai * 128 + m * 16; bf16_t* rowp = O + (size_t)row * NPROJ + col0;
#pragma unroll
                for (int bj = 0; bj < 2; ++bj) { f32x4 v0 = acc[ai][bj][m][0], v1 = acc[ai][bj][m][1];
                    const bool is_q = (u.pn >= 16 && u.pn < 20), is_k = (u.pn == 20 && bj == 0);
                    if (is_q || is_k) {
                        const f32x4 r0 = rp[m][bj][0], r1 = rp[m][bj][1];
                        const float sc = is_q ? 0.125f : 1.0f;
                        f32x4 w0, w1;
                        w0.x = (v0.x * r0.x - v0.y * r0.y) * sc; w0.y = (v0.y * r0.x + v0.x * r0.y) * sc; w0.z = (v0.z * r0.z - v0.w * r0.w) * sc; w0.w = (v0.w * r0.z + v0.z * r0.w) * sc;
                        w1.x = (v1.x * r1.x - v1.y * r1.y) * sc; w1.y = (v1.y * r1.x + v1.x * r1.y) * sc; w1.z = (v1.z * r1.z - v1.w * r1.w) * sc; w1.w = (v1.w * r1.z + v1.z * r1.w) * sc;
                        v0 = w0; v1 = w1;
                    }
                    if (u.pn == 21) { if (bj == 0 && wc == 0 && fq < 2) { *(f32x4*)(BA + (size_t)row * 16 + 8 * fq) = v0; *(f32x4*)(BA + (size_t)row * 16 + 8 * fq + 4) = v1; } }
                    else { u32x4 w; w.x = cvtpk(v0.x, v0.y); w.y = cvtpk(v0.z, v0.w); w.z = cvtpk(v1.x, v1.y); w.w = cvtpk(v1.z, v1.w); *(u32x4*)(rowp + bj * 128) = w; } } }
        }
    }
};
struct EpiY {
    static constexpr bool PERM = true, AFTER_DRAIN = false;
    bf16_t* Y; const float* gate  ;
    DI void operator()(const pg8::f32x4 (&acc)[2][2][4][2], const pg8::Unit& u, int wr, int wc, int fr, int fq) const {
        const int row0 = u.pm * 256 + wr * 64 + fr, col0 = u.pn * 256 + wc * 32 + 8 * fq; const int b = (u.pm * 256) / T;
        f32x4 g[2][2];
#pragma unroll
        for (int bj = 0; bj < 2; ++bj)
#pragma unroll
            for (int n = 0; n < 2; ++n) g[bj][n] = *(const f32x4*)(gate + b * NMOD + col0 + bj * 128 + n * 4);
#pragma unroll
        for (int ai = 0; ai < 2; ++ai)
#pragma unroll
            for (int m = 0; m < 4; ++m) { bf16_t* rowp = Y + (size_t)(row0 + ai * 128 + m * 16) * D + col0;
#pragma unroll
                for (int bj = 0; bj < 2; ++bj) { const f32x4 v0 = acc[ai][bj][m][0] * g[bj][0], v1 = acc[ai][bj][m][1] * g[bj][1];
                    u32x4 w; w.x = cvtpk(v0.x, v0.y); w.y = cvtpk(v0.z, v0.w); w.z = cvtpk(v1.x, v1.y); w.w = cvtpk(v1.z, v1.w); *(u32x4*)(rowp + bj * 128) = w; } }
    }
};
struct EpiSwiglu {
    static constexpr bool PERM = true, AFTER_DRAIN = false;
    bf16_t* H;
    DI void operator()(const pg8::f32x4 (&acc)[2][2][4][2], const pg8::Unit& u, int wr, int wc, int fr, int fq) const {
        const int row0 = u.pm * 256 + wr * 64 + fr, col0 = u.pn * 128 + wc * 32 + 8 * fq;
#pragma unroll
        for (int ai = 0; ai < 2; ++ai)
#pragma unroll
            for (int m = 0; m < 4; ++m) { const f32x4 g0 = acc[ai][0][m][0], g1 = acc[ai][0][m][1], u0 = acc[ai][1][m][0], u1 = acc[ai][1][m][1];
                u32x4 w; w.x = cvtpk(silu(g0.x) * u0.x, silu(g0.y) * u0.y); w.y = cvtpk(silu(g0.z) * u0.z, silu(g0.w) * u0.w);
                w.z = cvtpk(silu(g1.x) * u1.x, silu(g1.y) * u1.y); w.w = cvtpk(silu(g1.z) * u1.z, silu(g1.w) * u1.w);
                *(u32x4*)(H + (size_t)(row0 + ai * 128 + m * 16) * FF + col0) = w; }
    }
};

DI void d1_phase(const Params& P, int l, int gw, int NGW, int lane) {
    typedef __attribute__((address_space(1))) const u32x4* gcu;
    const bf16_t* PROJ = (const bf16_t*)(P.ws + WS_PROJ); const float* cwp = P.conv_w + (size_t)l * 4 * 3072;
    constexpr int NIT = 1024 * 6;
#define D1_LOAD(RH, RV, IT) do { const int it_ = (IT); const int s_ = it_ % 6, m0_ = (it_ / 6) * 16, ch_ = 512 * s_ + 8 * lane; \
        _Pragma("unroll") for (int tt = 0; tt < 16; ++tt) RV[tt] = *(gcu)(PROJ + (size_t)(m0_ + tt) * NPROJ + ch_); } while (0)
#define D1_COMPUTE(RH, RV, IT) do { const int it_ = (IT); const int s_ = it_ % 6, m0 = (it_ / 6) * 16, b = m0 / T, t0 = m0 % T; \
        const int ch = 512 * s_ + 8 * lane, part = ch >> 10, h = (ch >> 7) & 7, d0 = ch & 127; \
        float cw[4][8]; \
        _Pragma("unroll") for (int j = 0; j < 4; ++j) { const f32x4 a = *(const f32x4*)(cwp + j * 3072 + ch), c2 = *(const f32x4*)(cwp + j * 3072 + ch + 4); \
            cw[j][0] = a.x; cw[j][1] = a.y; cw[j][2] = a.z; cw[j][3] = a.w; cw[j][4] = c2.x; cw[j][5] = c2.y; cw[j][6] = c2.z; cw[j][7] = c2.w; } \
        float xw[3][8]; \
        _Pragma("unroll") for (int j = 0; j < 3; ++j) { u32x4 raw = {0u, 0u, 0u, 0u}; if (t0 > 0) raw = *(gcu)(PROJ + (size_t)(m0 - 3 + j) * NPROJ + ch); \
            xw[j][0] = bflo(raw.x); xw[j][1] = bfhi(raw.x); xw[j][2] = bflo(raw.y); xw[j][3] = bfhi(raw.y); xw[j][4] = bflo(raw.z); xw[j][5] = bfhi(raw.z); xw[j][6] = bflo(raw.w); xw[j][7] = bfhi(raw.w); } \
        bf16_t* dst = (bf16_t*)(P.ws + (part == 0 ? WS_QN : (part == 1 ? WS_KN : WS_VN))) + ((size_t)(b * 8 + h) * T + t0) * 128 + d0; \
        _Pragma("unroll") for (int tt = 0; tt < 16; ++tt) { \
            const u32x4 raw = RV[tt]; \
            float xc[8] = {bflo(raw.x), bfhi(raw.x), bflo(raw.y), bfhi(raw.y), bflo(raw.z), bfhi(raw.z), bflo(raw.w), bfhi(raw.w)}; \
            float y[8]; float ss = 0.f; \
            _Pragma("unroll") for (int e = 0; e < 8; ++e) { const float a = cw[0][e] * xw[0][e] + cw[1][e] * xw[1][e] + cw[2][e] * xw[2][e] + cw[3][e] * xc[e]; y[e] = silu(a); ss += y[e] * y[e]; \
                xw[0][e] = xw[1][e]; xw[1][e] = xw[2][e]; xw[2][e] = xc[e]; } \
            float scale = 1.0f; \
            if (part < 2) { ss += __shfl_xor(ss, 1); ss += __shfl_xor(ss, 2); ss += __shfl_xor(ss, 4); ss += __shfl_xor(ss, 8); \
                scale = __builtin_amdgcn_rsqf(ss + EPS) * (part == 0 ? 0.08838834764831845f : 1.0f); } \
            u32x4 w; w.x = cvtpk(y[0] * scale, y[1] * scale); w.y = cvtpk(y[2] * scale, y[3] * scale); w.z = cvtpk(y[4] * scale, y[5] * scale); w.w = cvtpk(y[6] * scale, y[7] * scale); \
            *(u32x4*)(dst + (size_t)tt * 128) = w; } } while (0)
    u32x4 vA[16], vB[16]; int hA = 0, hB = 0; (void)hA; (void)hB;
    if (gw < NIT) D1_LOAD(hA, vA, gw);
#pragma unroll 1
    for (int it = gw; it < NIT; it += 2 * NGW) {
        if (it + NGW < NIT) D1_LOAD(hB, vB, it + NGW);
        D1_COMPUTE(hA, vA, it);
        if (it + NGW < NIT) {
            if (it + 2 * NGW < NIT) D1_LOAD(hA, vA, it + 2 * NGW);
            D1_COMPUTE(hB, vB, it + NGW);
        }
    }
#undef D1_LOAD
#undef D1_COMPUTE
}

DI bf16x8 pack8(const f32x16& x, int g) {
    u32x4 p; p.x = cvtpk(x[8 * g + 0], x[8 * g + 1]); p.y = cvtpk(x[8 * g + 2], x[8 * g + 3]); p.z = cvtpk(x[8 * g + 4], x[8 * g + 5]); p.w = cvtpk(x[8 * g + 6], x[8 * g + 7]);
    return __builtin_bit_cast(bf16x8, p);
}
constexpr int NMS = 68;
DI void d2_chunk(const Params& P, int l, int chunk, LAS float* Nm, LAS float* gs, int lane_in) {
    int lane = lane_in; asm volatile("" : "+v"(lane));
    const int bh = chunk >> 7, n = chunk & 127, b = bh >> 3, h = bh & 7, r = lane & 31, hi = lane >> 5;
    const float* BA = (const float*)(P.ws + WS_BA);
    const bf16_t* Kc = (const bf16_t*)(P.ws + WS_KN) + ((size_t)bh * T + n * 64) * 128;
    const bf16_t* Qc = (const bf16_t*)(P.ws + WS_QN) + ((size_t)bh * T + n * 64) * 128;
    const bf16_t* Vc = (const bf16_t*)(P.ws + WS_VN) + ((size_t)bh * T + n * 64) * 128;
    bf16_t* NWf = (bf16_t*)(P.ws + WS_NW) + (size_t)chunk * 8192; bf16_t* QGf = (bf16_t*)(P.ws + WS_QG) + (size_t)chunk * 8192;
    bf16_t* KDf = (bf16_t*)(P.ws + WS_KD) + (size_t)chunk * 8192; bf16_t* INf = (bf16_t*)(P.ws + WS_IN) + (size_t)chunk * 4096;
    bf16_t* UF = (bf16_t*)(P.ws + WS_UF) + (size_t)chunk * 8192;
    {
        const int m = b * T + n * 64 + lane;
        const float braw = BA[(size_t)m * 16 + h], araw = BA[(size_t)m * 16 + 8 + h];
        const float beta = 1.0f / (1.0f + expf(-braw));
        const float xs = araw + P.dt_bias[l * 8 + h]; const float sp = xs > 20.f ? xs : log1pf(expf(xs));
        float gc = -expf(P.a_log[l * 8 + h]) * sp;
#pragma unroll
        for (int o = 1; o < 64; o <<= 1) { const float tv = __shfl_up(gc, o); if (lane >= o) gc += tv; }
        gs[lane] = gc; gs[64 + lane] = beta; gs[128 + lane] = -beta * __expf(gc);
    }
    wave_lds_fence();
    const float gcl = gs[63];
    {
        f32x16 kk00, kk10, kk11, qk00, qk10, qk11;
#pragma unroll
        for (int i = 0; i < 16; ++i) { kk00[i] = 0.f; kk10[i] = 0.f; kk11[i] = 0.f; qk00[i] = 0.f; qk10[i] = 0.f; qk11[i] = 0.f; }
#pragma unroll 2
        for (int kk = 0; kk < 8; ++kk) {
            const bf16x8 k0 = *(const bf16x8*)(Kc + r * 128 + 16 * kk + 8 * hi), k1 = *(const bf16x8*)(Kc + (32 + r) * 128 + 16 * kk + 8 * hi);
            const bf16x8 q0 = *(const bf16x8*)(Qc + r * 128 + 16 * kk + 8 * hi), q1 = *(const bf16x8*)(Qc + (32 + r) * 128 + 16 * kk + 8 * hi);
            kk00 = MFMA32(k0, k0, kk00); kk10 = MFMA32(k0, k1, kk10); kk11 = MFMA32(k1, k1, kk11);
            qk00 = MFMA32(k0, q0, qk00); qk10 = MFMA32(k0, q1, qk10); qk11 = MFMA32(k1, q1, qk11);
        }
#define D2_TILE(KKT, QKT, tc, ts) do { const int cc = 32 * (tc) + r; const float gcc = gs[cc], bcc = gs[64 + cc]; \
            _Pragma("unroll") for (int i = 0; i < 16; ++i) { const int s = 32 * (ts) + crow(i, hi); \
                const float dec = (s <= cc) ? __expf(gcc - gs[s]) : 0.f; \
                Nm[cc * NMS + s] = (s < cc) ? bcc * KKT[i] * dec : 0.f; QKT[i] *= dec; } \
            *(bf16x8*)(INf + (((tc) * 4 + 2 * (ts)) * 64 + lane) * 8) = pack8(QKT, 0); *(bf16x8*)(INf + (((tc) * 4 + 2 * (ts) + 1) * 64 + lane) * 8) = pack8(QKT, 1); } while (0)
        D2_TILE(kk00, qk00, 0, 0); D2_TILE(kk10, qk10, 1, 0); D2_TILE(kk11, qk11, 1, 1);
#undef D2_TILE
        *(u32x4*)(INf + ((0 * 4 + 2) * 64 + lane) * 8) = (u32x4){0u, 0u, 0u, 0u};
        *(u32x4*)(INf + ((0 * 4 + 3) * 64 + lane) * 8) = (u32x4){0u, 0u, 0u, 0u};
    }
    wave_lds_fence();
    __builtin_amdgcn_sched_barrier(0); asm volatile("" ::: "memory");
    {
        float t[64];
        f32x4 ncur[16], nnext[16];
#define D2_LOADROW(DST, I) do { _Pragma("unroll") for (int q_ = 0; q_ < ((I) + 3) / 4; ++q_) DST[q_] = *(const LAS f32x4*)(Nm + (I) * NMS + 4 * q_); } while (0)
#pragma unroll
        for (int q = 0; q < 16; ++q) { ncur[q] = (f32x4){0.f, 0.f, 0.f, 0.f}; nnext[q] = ncur[q]; }
#define D2_TBLOCK(ib) do { \
            _Pragma("unroll") for (int ii = 0; ii < 16; ++ii) { const int i = 16 * (ib) + ii; \
                if (i + 1 < 64) D2_LOADROW(nnext, i + 1); \
                float a0 = (i == lane) ? 1.f : 0.f, a1 = 0.f, a2 = 0.f, a3 = 0.f; \
                _Pragma("unroll") for (int j = 0; j + 3 < i; j += 4) { fnma_(a0, ncur[j >> 2].x, t[j]); fnma_(a1, ncur[j >> 2].y, t[j + 1]); fnma_(a2, ncur[j >> 2].z, t[j + 2]); fnma_(a3, ncur[j >> 2].w, t[j + 3]); } \
                if ((i & 3) >= 1) fnma_(a0, ncur[i >> 2].x, t[i & ~3]); \
                if ((i & 3) >= 2) fnma_(a1, ncur[i >> 2].y, t[(i & ~3) + 1]); \
                if ((i & 3) >= 3) fnma_(a2, ncur[i >> 2].z, t[(i & ~3) + 2]); \
                const float a = (a0 + a1) + (a2 + a3); \
                t[i] = a; Nm[i * NMS + lane] = a; \
                _Pragma("unroll") for (int q = 0; q < 16; ++q) ncur[q] = nnext[q]; \
                __builtin_amdgcn_sched_barrier(0); } } while (0)
        D2_LOADROW(ncur, 0);
        D2_TBLOCK(0); D2_TBLOCK(1); D2_TBLOCK(2); D2_TBLOCK(3);
#undef D2_TBLOCK
#undef D2_LOADROW
    }
    wave_lds_fence();
    __builtin_amdgcn_sched_barrier(0); asm volatile("" ::: "memory");
    {
        bf16x8 Tfw[2][4], Tfu[2][4];
#pragma unroll
        for (int ct = 0; ct < 2; ++ct)
#pragma unroll
            for (int ks = 0; ks < 4; ++ks) { const LAS f32x4* tp = (const LAS f32x4*)(Nm + (32 * ct + r) * NMS + 16 * ks + 8 * hi); const f32x4 a = tp[0], c2 = tp[1];
                const LAS f32x4* fw = (const LAS f32x4*)(gs + 128 + 16 * ks + 8 * hi); const LAS f32x4* fb = (const LAS f32x4*)(gs + 64 + 16 * ks + 8 * hi);
                const f32x4 w0 = fw[0], w1 = fw[1], b0 = fb[0], b1 = fb[1];
                u32x4 p; p.x = cvtpk(a.x * w0.x, a.y * w0.y); p.y = cvtpk(a.z * w0.z, a.w * w0.w); p.z = cvtpk(c2.x * w1.x, c2.y * w1.y); p.w = cvtpk(c2.z * w1.z, c2.w * w1.w); Tfw[ct][ks] = __builtin_bit_cast(bf16x8, p);
                u32x4 q; q.x = cvtpk(a.x * b0.x, a.y * b0.y); q.y = cvtpk(a.z * b0.z, a.w * b0.w); q.z = cvtpk(c2.x * b1.x, c2.y * b1.y); q.w = cvtpk(c2.z * b1.z, c2.w * b1.w); Tfu[ct][ks] = __builtin_bit_cast(bf16x8, q); }
        wave_lds_fence();
        LAS bf16_t* Xs = (LAS bf16_t*)Nm;
#define D2_STAGE(SRC) do { _Pragma("unroll") for (int hb = 0; hb < 2; ++hb) { u32x4 sv[8]; \
            _Pragma("unroll") for (int i = 0; i < 8; ++i) sv[i] = *(const u32x4*)((SRC) + (size_t)(lane + 64 * (8 * hb + i)) * 8); \
            _Pragma("unroll") for (int i = 0; i < 8; ++i) *(LAS u32x4*)(Xs + (lane + 64 * (8 * hb + i)) * 8) = sv[i]; \
            __builtin_amdgcn_sched_barrier(0); } } while (0)
#define D2_XFRAG(dt, ks) ({ const LAS bf16_t* xp = Xs + (16 * (ks) + 8 * hi) * 128 + 32 * (dt) + r; \
            u32x4 pk_; pk_.x = (unsigned)xp[0] | ((unsigned)xp[128] << 16); pk_.y = (unsigned)xp[256] | ((unsigned)xp[384] << 16); \
            pk_.z = (unsigned)xp[512] | ((unsigned)xp[640] << 16); pk_.w = (unsigned)xp[768] | ((unsigned)xp[896] << 16); __builtin_bit_cast(bf16x8, pk_); })
        D2_STAGE(Kc);
        wave_lds_fence();
#pragma unroll 1
        for (int dt = 0; dt < 4; ++dt) {
            f32x16 wt0, wt1;
#pragma unroll
            for (int i = 0; i < 16; ++i) { wt0[i] = 0.f; wt1[i] = 0.f; }
#pragma unroll
            for (int ks = 0; ks < 4; ++ks) { const bf16x8 kfr = D2_XFRAG(dt, ks); wt0 = MFMA32(kfr, Tfw[0][ks], wt0); wt1 = MFMA32(kfr, Tfw[1][ks], wt1); }
            *(bf16x8*)(NWf + ((0 * 8 + 2 * dt) * 64 + lane) * 8) = pack8(wt0, 0); *(bf16x8*)(NWf + ((0 * 8 + 2 * dt + 1) * 64 + lane) * 8) = pack8(wt0, 1);
            *(bf16x8*)(NWf + ((1 * 8 + 2 * dt) * 64 + lane) * 8) = pack8(wt1, 0); *(bf16x8*)(NWf + ((1 * 8 + 2 * dt + 1) * 64 + lane) * 8) = pack8(wt1, 1);
        }
        __builtin_amdgcn_sched_barrier(0);
        {
            float k0[64], k1[64];
#pragma unroll
            for (int i = 0; i < 64; ++i) { const unsigned kv = *(const LAS unsigned*)(Xs + i * 128 + 2 * lane); const float f = __expf(gcl - gs[i]); k0[i] = bflo(kv) * f; k1[i] = bfhi(kv) * f; }
            const int j = lane >> 4, r0 = (2 * lane) & 31;
#pragma unroll
            for (int Gp = 0; Gp < 4; ++Gp)
#pragma unroll
                for (int hp = 0; hp < 2; ++hp) {
                    u32x4 o0, o1;
                    o0.x = cvtpk(k0[16 * Gp + 4 * hp + 0], k0[16 * Gp + 4 * hp + 1]); o0.y = cvtpk(k0[16 * Gp + 4 * hp + 2], k0[16 * Gp + 4 * hp + 3]);
                    o0.z = cvtpk(k0[16 * Gp + 4 * hp + 8], k0[16 * Gp + 4 * hp + 9]); o0.w = cvtpk(k0[16 * Gp + 4 * hp + 10], k0[16 * Gp + 4 * hp + 11]);
                    o1.x = cvtpk(k1[16 * Gp + 4 * hp + 0], k1[16 * Gp + 4 * hp + 1]); o1.y = cvtpk(k1[16 * Gp + 4 * hp + 2], k1[16 * Gp + 4 * hp + 3]);
                    o1.z = cvtpk(k1[16 * Gp + 4 * hp + 8], k1[16 * Gp + 4 * hp + 9]); o1.w = cvtpk(k1[16 * Gp + 4 * hp + 10], k1[16 * Gp + 4 * hp + 11]);
                    *(u32x4*)(KDf + (((j * 4 + Gp) * 64) + r0 + 32 * hp) * 8) = o0;
                    *(u32x4*)(KDf + (((j * 4 + Gp) * 64) + r0 + 1 + 32 * hp) * 8) = o1;
                }
        }
        __builtin_amdgcn_sched_barrier(0);
        wave_lds_fence();
        D2_STAGE(Vc);
        wave_lds_fence();
#pragma unroll 1
        for (int dt = 0; dt < 4; ++dt) {
            f32x16 u0, u1;
#pragma unroll
            for (int i = 0; i < 16; ++i) { u0[i] = 0.f; u1[i] = 0.f; }
#pragma unroll
            for (int ks = 0; ks < 4; ++ks) { const bf16x8 vfr = D2_XFRAG(dt, ks); u0 = MFMA32(Tfu[0][ks], vfr, u0); u1 = MFMA32(Tfu[1][ks], vfr, u1); }
            *(bf16x8*)(UF + ((dt * 2 + 0) * 64 + lane) * 16) = pack8(u0, 0); *(bf16x8*)(UF + ((dt * 2 + 0) * 64 + lane) * 16 + 8) = pack8(u0, 1);
            *(bf16x8*)(UF + ((dt * 2 + 1) * 64 + lane) * 16) = pack8(u1, 0); *(bf16x8*)(UF + ((dt * 2 + 1) * 64 + lane) * 16 + 8) = pack8(u1, 1);
        }
#undef D2_STAGE
#undef D2_XFRAG
        wave_lds_fence();
    }
    __builtin_amdgcn_sched_barrier(0); asm volatile("" ::: "memory");
#pragma unroll
    for (int t = 0; t < 2; ++t) { const float f = __expf(gs[32 * t + r]); const bf16_t* qrow = Qc + (32 * t + r) * 128 + 4 * hi;
#pragma unroll
        for (int G = 0; G < 8; ++G) { const u32x2 a = *(const u32x2*)(qrow + 16 * G), c2 = *(const u32x2*)(qrow + 16 * G + 8);
            u32x4 o; o.x = cvtpk(bflo(a.x) * f, bfhi(a.x) * f); o.y = cvtpk(bflo(a.y) * f, bfhi(a.y) * f); o.z = cvtpk(bflo(c2.x) * f, bfhi(c2.x) * f); o.w = cvtpk(bflo(c2.y) * f, bfhi(c2.y) * f);
            *(u32x4*)(QGf + ((t * 8 + G) * 64 + lane) * 8) = o; } }
    __builtin_amdgcn_sched_barrier(0); asm volatile("" ::: "memory");
    if (lane == 0) ((float*)(P.ws + WS_GL))[chunk] = __expf(gcl);
    wave_lds_fence();
}

#define D3_LD(BASE, OFF) (*(const u32x4*)((BASE) + (OFF) + (size_t)voff))
#define D3_ISSUE(V, CH) do { const size_t ch_ = (size_t)(CH); const unsigned voff = (unsigned)ltid * 16u; \
        const char* s0 = (const char*)P.ws + WS_NW + ch_ * 16384; const char* s1 = (const char*)P.ws + WS_QG + ch_ * 16384; \
        const char* s2 = (const char*)P.ws + WS_IN + ch_ * 8192; const char* s3 = (const char*)P.ws + WS_KD + ch_ * 16384; const char* s4 = (const char*)P.ws + WS_UF + ch_ * 16384 + (size_t)vs * 4096; \
        _Pragma("unroll") for (int i = 0; i < 4; ++i) { V[i] = D3_LD(s0, 4096 * i); V[4 + i] = D3_LD(s1, 4096 * i); V[10 + i] = D3_LD(s3, 4096 * i); } \
        V[8] = D3_LD(s2, 0); V[9] = D3_LD(s2, 4096); V[14] = D3_LD(s4, 0); } while (0)
#define D3_WRITE(V, SLOT) do { LAS u32x4* d = (LAS u32x4*)(SLOT) + ltid; \
        _Pragma("unroll") for (int i = 0; i < 4; ++i) { d[256 * i] = V[i]; d[1024 + 256 * i] = V[4 + i]; d[2560 + 256 * i] = V[10 + i]; } \
        d[2048] = V[8]; d[2048 + 256] = V[9]; d[3584] = V[14]; } while (0)
#define D3_BAR() do { asm volatile("s_waitcnt lgkmcnt(0)" ::: "memory"); __builtin_amdgcn_s_barrier(); asm volatile("" ::: "memory"); } while (0)
constexpr int D3_EXSB = 2 * D3_SLOT, D3_EXVB = D3_EXSB + 8192;
DI void d3_block(const Params& P, int bh, int vs, LAS unsigned char* lds, int wave, int lane, int tid) {
    const int b = bh >> 3, h = bh & 7, r = lane & 31, hi = lane >> 5, ltid = tid - 256, ch0 = bh * 128;
    const float* GL = (const float*)(P.ws + WS_GL) + ch0;
    float* ODN = (float*)(P.ws + WS_ODN);
    LAS bf16x8* exSb = (LAS bf16x8*)(lds + D3_EXSB) + lane; LAS bf16x8* exVb = (LAS bf16x8*)(lds + D3_EXVB) + lane;
    LAS float* ostage0 = (LAS float*)(lds + D3_EXVB + 4096);
    volatile LAS unsigned* vflag = (volatile LAS unsigned*)(lds + D3_EXVB + 4096 + 2 * 9216);
    if (wave >= 4) {
        u32x4 VA[15], VB[15], VC[15];
        D3_ISSUE(VA, ch0); D3_ISSUE(VB, ch0 + 1); D3_ISSUE(VC, ch0 + 2); D3_WRITE(VA, lds); D3_ISSUE(VA, ch0 + 3);
        D3_BAR();
#define D3_LSTEP(N, VNEXT) do { const int n_ = (N); const int nx_ = (n_ + 4 < 127) ? n_ + 4 : 127; \
            D3_WRITE(VNEXT, lds + ((n_ + 1) & 1) * D3_SLOT); D3_ISSUE(VNEXT, ch0 + nx_); \
            D3_BAR(); } while (0)
#pragma unroll 1
        for (int n0 = 0; n0 < 126; n0 += 3) { D3_LSTEP(n0, VB); D3_LSTEP(n0 + 1, VC); D3_LSTEP(n0 + 2, VA); }
        D3_LSTEP(126, VB);
        D3_BAR();
        asm volatile("s_waitcnt vmcnt(0)" ::: "memory");
#undef D3_LSTEP
    } else if (wave == 0) {
        f32x16 S[4]; bf16x8 Sb[8];
#pragma unroll
        for (int j = 0; j < 4; ++j)
#pragma unroll
            for (int i = 0; i < 16; ++i) S[j][i] = 0.f;
#pragma unroll
        for (int G = 0; G < 8; ++G) { Sb[G] = (bf16x8){0, 0, 0, 0, 0, 0, 0, 0}; exSb[G * 64] = Sb[G]; }
        if (lane == 0) *vflag = 0u;
        D3_BAR();
        float gl = GL[0];
#pragma unroll 1
        for (int n = 0; n < 128; ++n) {
            const LAS unsigned char* sb = lds + (n & 1) * D3_SLOT;
            const LAS bf16x8* fNW = (const LAS bf16x8*)sb + lane; const LAS bf16x8* fKD = (const LAS bf16x8*)(sb + 40960) + lane;
            const LAS u32x4* fU = (const LAS u32x4*)(sb + 57344) + lane * 2;
            const float gl_next = GL[(n + 1) & 127];
            bf16x8 fw[16];
#pragma unroll
            for (int q = 0; q < 16; ++q) fw[q] = fNW[q * 64];
            f32x16 vt[2];
#pragma unroll
            for (int t = 0; t < 2; ++t) { const u32x4 a = fU[t * 128], b2 = fU[t * 128 + 1];
                vt[t][0] = bflo(a.x); vt[t][1] = bfhi(a.x); vt[t][2] = bflo(a.y); vt[t][3] = bfhi(a.y); vt[t][4] = bflo(a.z); vt[t][5] = bfhi(a.z); vt[t][6] = bflo(a.w); vt[t][7] = bfhi(a.w);
                vt[t][8] = bflo(b2.x); vt[t][9] = bfhi(b2.x); vt[t][10] = bflo(b2.y); vt[t][11] = bfhi(b2.y); vt[t][12] = bflo(b2.z); vt[t][13] = bfhi(b2.z); vt[t][14] = bflo(b2.w); vt[t][15] = bfhi(b2.w); }
            __builtin_amdgcn_sched_barrier(0);
#pragma unroll
            for (int G = 0; G < 8; ++G) {
                vt[0] = MFMA32(fw[G], Sb[G], vt[0]); vt[1] = MFMA32(fw[8 + G], Sb[G], vt[1]);
                if (G < 4) {
#pragma unroll
                    for (int i = 0; i < 16; ++i) S[G][i] *= gl; } }
            __builtin_amdgcn_sched_barrier(0);
            bf16x8 fk[16];
#pragma unroll
            for (int q = 0; q < 16; ++q) fk[q] = fKD[q * 64];
            __builtin_amdgcn_sched_barrier(0);
            bf16x8 Vb[4];
            Vb[0] = pack8(vt[0], 0); Vb[1] = pack8(vt[0], 1); Vb[2] = pack8(vt[1], 0); Vb[3] = pack8(vt[1], 1);
#pragma unroll
            for (int G = 0; G < 4; ++G) exVb[G * 64] = Vb[G];
            asm volatile("s_waitcnt lgkmcnt(0)" ::: "memory");
            if (lane == 0) *vflag = (unsigned)(n + 1);
#pragma unroll
            for (int G = 0; G < 4; ++G) { S[0] = MFMA32(fk[G], Vb[G], S[0]); S[1] = MFMA32(fk[4 + G], Vb[G], S[1]); S[2] = MFMA32(fk[8 + G], Vb[G], S[2]); S[3] = MFMA32(fk[12 + G], Vb[G], S[3]); }
            __builtin_amdgcn_sched_barrier(0);
#pragma unroll
            for (int j = 0; j < 4; ++j) { Sb[2 * j] = pack8(S[j], 0); Sb[2 * j + 1] = pack8(S[j], 1); exSb[(2 * j) * 64] = Sb[2 * j]; exSb[(2 * j + 1) * 64] = Sb[2 * j + 1]; }
            gl = gl_next;
            D3_BAR();
        }
    } else if (wave == 1) {
        D3_BAR();
#pragma unroll 1
        for (int n = 0; n < 128; ++n) {
            const LAS unsigned char* sb = lds + (n & 1) * D3_SLOT;
            const LAS bf16x8* fQG = (const LAS bf16x8*)(sb + 16384) + lane; const LAS bf16x8* fIN = (const LAS bf16x8*)(sb + 32768) + lane;
            bf16x8 Sb[8], fq[16];
#pragma unroll
            for (int G = 0; G < 8; ++G) Sb[G] = exSb[G * 64];
#pragma unroll
            for (int q = 0; q < 16; ++q) fq[q] = fQG[q * 64];
            f32x16 ot[2];
#pragma unroll
            for (int i = 0; i < 16; ++i) { ot[0][i] = 0.f; ot[1][i] = 0.f; }
            __builtin_amdgcn_sched_barrier(0);
#pragma unroll
            for (int G = 0; G < 8; ++G) { ot[0] = MFMA32(fq[G], Sb[G], ot[0]); ot[1] = MFMA32(fq[8 + G], Sb[G], ot[1]); }
            __builtin_amdgcn_sched_barrier(0);
            bf16x8 fi[8];
#pragma unroll
            for (int q = 0; q < 8; ++q) fi[q] = fIN[q * 64];
            { unsigned spins = 0; while (*vflag < (unsigned)(n + 1) && ++spins < (1u << 22)) __builtin_amdgcn_s_sleep(1); }
            asm volatile("" ::: "memory");
            bf16x8 Vb[4];
#pragma unroll
            for (int G = 0; G < 4; ++G) Vb[G] = exVb[G * 64];
#pragma unroll
            for (int G = 0; G < 4; ++G) { ot[0] = MFMA32(fi[G], Vb[G], ot[0]); ot[1] = MFMA32(fi[4 + G], Vb[G], ot[1]); }
#pragma unroll
            for (int t = 0; t < 2; ++t)
#pragma unroll
                for (int i = 0; i < 16; ++i) (ostage0 + (n & 1) * 2304)[(32 * t + (i & 3) + 8 * (i >> 2) + 4 * hi) * 36 + r] = ot[t][i];
            D3_BAR();
        }
    } else {
        const int row0 = 32 * (wave - 2) + (lane >> 3), col4 = 4 * (lane & 7);
        float* orow = ODN + (size_t)(b * T + row0) * 1024 + h * 128 + vs * 32 + col4;
        D3_BAR();
#pragma unroll 1
        for (int n = 0; n <= 128; ++n) {
            if (n > 0) {
#pragma unroll
                for (int j = 0; j < 4; ++j) { const f32x4 v = *(const LAS f32x4*)(ostage0 + ((n - 1) & 1) * 2304 + (row0 + 8 * j) * 36 + col4); *(f32x4*)(orow + (size_t)((n - 1) * 64 + 8 * j) * 1024) = v; } }
            if (n < 128) D3_BAR();
        }
    }
}
#undef D3_ISSUE
#undef D3_WRITE
#undef D3_BAR
#undef D3_LD

DI void att_unit(const Params& P, int l, int unit, LAS unsigned char* lds, int wave, int lane, int tid) {
    const int qblk = unit & 63, kvh = (unit >> 6) & 1, b = unit >> 7, r = lane & 31, hi = lane >> 5;
    const bf16_t* PROJ = (const bf16_t*)(P.ws + WS_PROJ); bf16_t* MIX = (bf16_t*)(P.ws + WS_ACT);
    LAS bf16_t* Ks = (LAS bf16_t*)lds;
    LAS bf16_t* Vt = (LAS bf16_t*)(lds + 36864);
    const int kpos0 = (qblk - 1) * 128;
#pragma unroll
    for (int i = 0; i < 4; ++i) { const int p = tid + 512 * i, key = p >> 3, dp = p & 7; const int kp = kpos0 + key;
        u32x4 kv = {0u, 0u, 0u, 0u}, vv = {0u, 0u, 0u, 0u};
        if (kp >= 0) { const bf16_t* src = PROJ + (size_t)(b * T + kp) * NPROJ; kv = *(const u32x4*)(src + C_K + kvh * 64 + 8 * dp); vv = *(const u32x4*)(src + C_V + kvh * 64 + 8 * dp); }
        *(LAS u32x4*)(Ks + key * 72 + 8 * dp) = kv;
        const int pk = swap23(key); LAS bf16_t* vd = Vt + (8 * dp) * 264 + pk;
        vd[0 * 264] = (bf16_t)(vv.x & 0xffffu); vd[1 * 264] = (bf16_t)(vv.x >> 16); vd[2 * 264] = (bf16_t)(vv.y & 0xffffu); vd[3 * 264] = (bf16_t)(vv.y >> 16);
        vd[4 * 264] = (bf16_t)(vv.z & 0xffffu); vd[5 * 264] = (bf16_t)(vv.z >> 16); vd[6 * 264] = (bf16_t)(vv.w & 0xffffu); vd[7 * 264] = (bf16_t)(vv.w >> 16); }
    __syncthreads();
    const int qh = kvh * 8 + wave; const float sink = P.sinks[l * 16 + qh];
    for (int qt = 0; qt < 4; ++qt) {
        const int mrow = b * T + qblk * 128 + 32 * qt + r;
        bf16x8 qf[4];
#pragma unroll
        for (int kk = 0; kk < 4; ++kk) qf[kk] = *(const bf16x8*)(PROJ + (size_t)mrow * NPROJ + C_Q + qh * 64 + 16 * kk + 8 * hi);
        f32x16 st[5];
        const int rq = 32 * qt + r; float mx = -INFINITY;
        const int jlo = (qblk > 0 || rq + 1 >= 128) ? rq + 1 : 128; const unsigned jspan = (unsigned)(rq + 128 - jlo);
#pragma unroll
        for (int i = 0; i < 5; ++i) { const int kt = qt + i;
#pragma unroll
            for (int e = 0; e < 16; ++e) st[i][e] = 0.f;
#pragma unroll
            for (int kk = 0; kk < 4; ++kk) st[i] = MFMA32(*(const LAS bf16x8*)(Ks + (32 * kt + r) * 72 + 16 * kk + 8 * hi), qf[kk], st[i]);
#pragma unroll
            for (int e = 0; e < 16; ++e) { const int j = 32 * kt + crow(e, hi); const bool valid = (unsigned)(j - jlo) <= jspan;
                st[i][e] = valid ? st[i][e] : -INFINITY; mx = fmaxf(mx, st[i][e]); }
            __builtin_amdgcn_sched_barrier(0); }
        mx = fmaxf(mx, __shfl_xor(mx, 32)); mx = fmaxf(mx, sink);
        float sum = 0.f;
#pragma unroll
        for (int i = 0; i < 5; ++i)
#pragma unroll
            for (int e = 0; e < 16; ++e) { const float p = __expf(st[i][e] - mx); st[i][e] = p; sum += p; }
        sum += __shfl_xor(sum, 32);
        const float inv = 1.0f / (sum + __expf(sink - mx));
        f32x16 ot[2];
#pragma unroll
        for (int e = 0; e < 16; ++e) { ot[0][e] = 0.f; ot[1][e] = 0.f; }
#pragma unroll
        for (int i = 0; i < 5; ++i) { const int kt = qt + i;
#pragma unroll
            for (int g = 0; g < 2; ++g) { const bf16x8 pb = pack8(st[i], g);
                ot[0] = MFMA32(*(const LAS bf16x8*)(Vt + (r) * 264 + 16 * (2 * kt + g) + 8 * hi), pb, ot[0]);
                ot[1] = MFMA32(*(const LAS bf16x8*)(Vt + (32 + r) * 264 + 16 * (2 * kt + g) + 8 * hi), pb, ot[1]); } }
        bf16_t* op = MIX + (size_t)mrow * D + 1024 + qh * 64;
#pragma unroll
        for (int dt = 0; dt < 2; ++dt)
#pragma unroll
            for (int a = 0; a < 4; ++a) { u32x2 w; w.x = cvtpk(ot[dt][4 * a] * inv, ot[dt][4 * a + 1] * inv); w.y = cvtpk(ot[dt][4 * a + 2] * inv, ot[dt][4 * a + 3] * inv);
                *(u32x2*)(op + 32 * dt + 8 * a + 4 * hi) = w; }
    }
    __syncthreads();
}

DI void d4_phase(const Params& P, int l, int gw, int NGW, int lane) {
    const float* ODN = (const float*)(P.ws + WS_ODN); const bf16_t* PROJ = (const bf16_t*)(P.ws + WS_PROJ); bf16_t* MIX = (bf16_t*)(P.ws + WS_ACT);
    const int d0 = (lane & 7) * 16; const float* nw = P.norm_w + l * 128 + d0;
    f32x4 g[4];
#pragma unroll
    for (int j = 0; j < 4; ++j) g[j] = *(const f32x4*)(nw + 4 * j);
    typedef __attribute__((address_space(1))) const f32x4* gcf; typedef __attribute__((address_space(1))) const u32x4* gcu;
    for (int mb = gw; mb < M; mb += 4 * NGW) {
        f32x4 vv[4][4]; u32x4 zz[4][2];
#pragma unroll
        for (int q = 0; q < 4; ++q) { const int m = mb + q * NGW; if (m < M) {
#pragma unroll
            for (int j = 0; j < 4; ++j) vv[q][j] = ((gcf)(ODN + (size_t)m * 1024 + lane * 16))[j];
            zz[q][0] = *(gcu)(PROJ + (size_t)m * NPROJ + C_Z + lane * 16); zz[q][1] = *(gcu)(PROJ + (size_t)m * NPROJ + C_Z + lane * 16 + 8); } }
#pragma unroll
        for (int q = 0; q < 4; ++q) { const int m = mb + q * NGW; if (m < M) {
            float ss = 0.f;
#pragma unroll
            for (int j = 0; j < 4; ++j) ss += (vv[q][j].x * vv[q][j].x + vv[q][j].y * vv[q][j].y) + (vv[q][j].z * vv[q][j].z + vv[q][j].w * vv[q][j].w);
            ss += __shfl_xor(ss, 1); ss += __shfl_xor(ss, 2); ss += __shfl_xor(ss, 4);
            const float rstd = __builtin_amdgcn_rsqf(ss * (1.0f / 128.f) + EPS);
            const u32x4 z0 = zz[q][0], z1 = zz[q][1];
            const float zf[16] = {bflo(z0.x), bfhi(z0.x), bflo(z0.y), bfhi(z0.y), bflo(z0.z), bfhi(z0.z), bflo(z0.w), bfhi(z0.w), bflo(z1.x), bfhi(z1.x), bflo(z1.y), bfhi(z1.y), bflo(z1.z), bfhi(z1.z), bflo(z1.w), bfhi(z1.w)};
            float y[16];
#pragma unroll
            for (int j = 0; j < 4; ++j) { y[4 * j] = vv[q][j].x * rstd * g[j].x * silu(zf[4 * j]); y[4 * j + 1] = vv[q][j].y * rstd * g[j].y * silu(zf[4 * j + 1]);
                y[4 * j + 2] = vv[q][j].z * rstd * g[j].z * silu(zf[4 * j + 2]); y[4 * j + 3] = vv[q][j].w * rstd * g[j].w * silu(zf[4 * j + 3]); }
            u32x4 w0, w1; w0.x = cvtpk(y[0], y[1]); w0.y = cvtpk(y[2], y[3]); w0.z = cvtpk(y[4], y[5]); w0.w = cvtpk(y[6], y[7]); w1.x = cvtpk(y[8], y[9]); w1.y = cvtpk(y[10], y[11]); w1.z = cvtpk(y[12], y[13]); w1.w = cvtpk(y[14], y[15]);
            *(u32x4*)(MIX + (size_t)m * D + lane * 16) = w0; *(u32x4*)(MIX + (size_t)m * D + lane * 16 + 8) = w1; } }
    }
}

#define XB_TMO      128
#define XB_XCNT(j)  (256  + 64 * (j))
#define XB_XSUB(j)  (1280 + 64 * (j))
#define XB_XGEN(j)  (2304 + 64 * (j))
#define XB_TOP      3328
#define XB_TOPGEN   3392
#define XCD_BAR_WORDS 3456
#define XB_SPIN_CAP (1u << 18)

__device__ __forceinline__ unsigned xb_ld(unsigned* p)              { return __hip_atomic_load(p, __ATOMIC_RELAXED, __HIP_MEMORY_SCOPE_AGENT); }
__device__ __forceinline__ unsigned xb_add(unsigned* p, unsigned v) { return __hip_atomic_fetch_add(p, v, __ATOMIC_RELAXED, __HIP_MEMORY_SCOPE_AGENT); }
__device__ __forceinline__ unsigned xb_xcc_id() { return (unsigned)__builtin_amdgcn_s_getreg((3 << 11) | 20) & 0xFu; }
#define XB_SPIN(cond, bar) do { unsigned _sp = 0; while (cond) { __builtin_amdgcn_s_sleep(1); \
    if ((++_sp & 255u) == 0u) { if (xb_ld(&(bar)[XB_TMO])) break; if (_sp > XB_SPIN_CAP) { atomicAdd(&(bar)[XB_TMO], 1u); break; } } } } while (0)

struct XcdBarrier {
    unsigned* bar; unsigned x;
    volatile LAS unsigned* st;
};

__device__ __forceinline__ XcdBarrier xcd_barrier_post(unsigned* bar, volatile LAS unsigned* st) {
    XcdBarrier b; b.bar = bar; b.x = xb_xcc_id(); b.st = st;
    if (threadIdx.x == 0) (void)xb_add(&bar[XB_XCNT(b.x)], 1u);
    return b;
}
__device__ __forceinline__ void xcd_barrier_complete(unsigned* bar, unsigned x, unsigned& nloc, unsigned& nx) {
    const unsigned G = gridDim.x * gridDim.y * gridDim.z;
    unsigned sum, cnt, mine, sp = 0u;
    for (;;) {
        sum = 0u; cnt = 0u; mine = 0u;
#pragma unroll
        for (unsigned j = 0; j < 16; ++j) { const unsigned c = xb_ld(&bar[XB_XCNT(j)]); sum += c; cnt += (c > 0u) ? 1u : 0u; mine = (j == x) ? c : mine; }
        if (sum == G) break;
        __builtin_amdgcn_s_sleep(1);
        if ((++sp & 255u) == 0u) { if (xb_ld(&bar[XB_TMO])) break; if (sp > XB_SPIN_CAP) { atomicAdd(&bar[XB_TMO], 1u); break; } }
    }
    nloc = mine > 0u ? mine : 1u; nx = cnt > 0u ? cnt : 1u;
}

__device__ __forceinline__ void xcd_barrier(const XcdBarrier& b) {
    asm volatile("s_waitcnt vmcnt(0)" ::: "memory");
    __syncthreads();
    if (threadIdx.x == 0) {
        unsigned* bar = b.bar;
        __builtin_amdgcn_s_waitcnt(0);
        unsigned nloc = b.st[0], nx = b.st[1];
        if (nloc == 0u) { xcd_barrier_complete(bar, b.x, nloc, nx); b.st[0] = nloc; b.st[1] = nx; }
        const unsigned old = xb_add(&bar[XB_XSUB(b.x)], 1u);
        const unsigned gen = old / nloc;
        if (old + 1u == (gen + 1u) * nloc) {
            __builtin_amdgcn_fence(__ATOMIC_RELEASE, "agent");
            asm volatile("s_waitcnt vmcnt(0)" ::: "memory");
            const unsigned og = xb_add(&bar[XB_TOP], 1u);
            const unsigned tg = og / nx;
            if (og + 1u == (tg + 1u) * nx) xb_add(&bar[XB_TOPGEN], 1u);
            else XB_SPIN(xb_ld(&bar[XB_TOPGEN]) == tg, bar);
            __builtin_amdgcn_fence(__ATOMIC_ACQUIRE, "agent");
            xb_add(&bar[XB_XGEN(b.x)], 1u);
            asm volatile("s_waitcnt vmcnt(0)" ::: "memory");
        } else {
            XB_SPIN(xb_ld(&bar[XB_XGEN(b.x)]) == gen, bar);
            __builtin_amdgcn_fence(__ATOMIC_ACQUIRE, "agent");
            asm volatile("s_waitcnt vmcnt(0)" ::: "memory");
        }
    }
    __syncthreads();
}

constexpr int N_PHASES = 23;
#ifndef USE_XCD_BARRIER
#define USE_XCD_BARRIER 1
#endif
#ifndef PHASE_MASK
#define PHASE_MASK 0xffff
#endif
#define EN(k) if constexpr (((PHASE_MASK) >> (k)) & 1)
__global__ void __launch_bounds__(512, 2) fwd_kernel(Params PK) {
    extern __shared__ __attribute__((aligned(16))) unsigned char lds_raw[];
    LAS unsigned char* lds = (LAS unsigned char*)lds_raw;
    cg::grid_group grid = cg::this_grid();
    volatile LAS unsigned* bst = (volatile LAS unsigned*)(lds + LDS_BYTES - 64);
    if (threadIdx.x < 2) bst[threadIdx.x] = 0u;
    __syncthreads();
    const XcdBarrier xbar = xcd_barrier_post((unsigned*)(PK.ws + WS_CTL), bst);
    const int G = gridDim.x, NGW = G * 8;
#ifndef DOUBLE_MASK
#define DOUBLE_MASK 0
#endif
#ifndef DOUBLE_PH_END
#define DOUBLE_PH_END 22
#endif
#ifndef DOUBLE_P0
#define DOUBLE_P0 0
#endif
    for (int it = 0, ph = PK.ph_lo, rep = 0; ph < PK.ph_hi; ++it, ((rep == 0 && ((ph >= 2 && ph < DOUBLE_PH_END && ((DOUBLE_MASK >> ((ph - 2) % 10)) & 1)) || (DOUBLE_P0 && ph == 0))) ? (rep = 1) : (rep = 0, ++ph))) {
        if (!USE_XCD_BARRIER || PK.ph_lo > 1000) { if (it > 0) grid.sync(); } else if (it > 0) xcd_barrier(xbar);
        Params P = PK;
        { typedef __attribute__((address_space(1))) unsigned char* gptr; typedef __attribute__((address_space(1))) float* gfp; typedef __attribute__((address_space(1))) const float* gcfp;
          gptr gws = (gptr)PK.ws; gfp gout = (gfp)PK.out; gcfp gx = (gcfp)PK.x; asm volatile("" : "+s"(gws), "+s"(gout), "+s"(gx));
          P.ws = (unsigned char*)gws; P.out = (float*)gout; P.x = (const float*)gx; }
        int tid = threadIdx.x; asm volatile("" : "+v"(tid));
        const int lane = tid & 63, wave = __builtin_amdgcn_readfirstlane(tid >> 6), gw = blockIdx.x * 8 + wave;
        bf16_t* ACT = (bf16_t*)(P.ws + WS_ACT); bf16_t* PROJ = (bf16_t*)(P.ws + WS_PROJ);
        const float* MOD = (const float*)(P.ws + WS_MOD);
        if (ph == 0) { EN(10) p0_phase(P, lds, gw, NGW, wave, lane); continue; }
        if (ph == 1) { EN(11) mod_phase(P, gw, NGW, lane); continue; }
        bf16_t* YB = (bf16_t*)(P.ws + WS_QN);
        bf16_t* XR = (bf16_t*)(P.ws + WS_XR);
        if (ph == 22) { EN(12) norm_phase<1, true>(XR, YB, nullptr, P.out, P.ln_final, nullptr, 0, 0, nullptr, gw, NGW, lane); continue; }
        const int l = (ph - 2) / 10, sp = (ph - 2) % 10;
        const float* modl = MOD + (size_t)l * 2 * NMOD;
        const float* xin = (l == 0) ? P.x : P.out;
        switch (sp) {
        case 0: EN(0) { if (l == 0) norm_phase<0, false>(P.x, nullptr, nullptr, nullptr, P.ln_mix, modl, 0, 2048, ACT, gw, NGW, lane);
                        else norm_phase<0, true>(XR, YB, XR, nullptr, P.ln_mix + l * D, modl, 0, 2048, ACT, gw, NGW, lane); } break;
        case 1: EN(1) { pg8::Gemm g{ACT, (const bf16_t*)(P.ws + WS_WIN) + (size_t)l * NPROJ * D, M, NPROJ, D}; pg8::StaticOrder S; S.init(M, NPROJ, G, (int)blockIdx.x);
            EpiIn E{PROJ, (float*)(P.ws + WS_BA), (const float*)(P.ws + WS_ROPE)};
            pg8::gemm_phase<EpiIn, pg8::StaticOrder, true, true>(lds, g, S, E, tid); } break;
        case 2: EN(2) d1_phase(P, l, gw, NGW, lane); break;
        case 3: EN(3) { LAS float* Nm = (LAS float*)(lds + wave * (64 * NMS * 4)); LAS float* gs = (LAS float*)(lds + 8 * (64 * NMS * 4) + wave * 1024);
            for (int ch = gw; ch < 2048; ch += NGW) d2_chunk(P, l, ch, Nm, gs, lane); } break;
#ifndef DOUBLE_SUB
#define DOUBLE_SUB 3
#endif
        case 4: if ((int)blockIdx.x < 64) { if (rep == 0 || (DOUBLE_SUB & 1)) { const int bx = (int)blockIdx.x, xq = bx >> 3;
                        EN(4) d3_block(P, 2 * (bx & 7) + (xq >> 2), xq & 3, lds, wave, lane, tid); } }
                else if (rep == 0 || (DOUBLE_SUB & 2)) { EN(13) for (int u = (int)blockIdx.x - 64; u < 256; u += G - 64) att_unit(P, l, u, lds, wave, lane, tid);
                    if (rep == 0) { EN(10) convert_items(P, lds, l == 0 ? I_IN : I_L + I_IN, l == 0 ? I_L + I_IN : 2 * I_L, ((int)blockIdx.x - 64) * 8 + wave, (G - 64) * 8, wave, lane); } }
                break;
        case 5: EN(5) d4_phase(P, l, gw, NGW, lane); break;
        case 6: EN(6) { pg8::Gemm g{ACT, (const bf16_t*)(P.ws + WS_WOUT) + (size_t)l * D * D, M, D, D}; pg8::StaticOrder S; S.init(M, D, G, (int)blockIdx.x);
            EpiY E{YB, modl + 4096};
            pg8::gemm_phase<EpiY, pg8::StaticOrder, true, true>(lds, g, S, E, tid); } break;
        case 7: EN(7) { if (l == 0) norm_phase<0, false>(P.x, YB, XR, nullptr, P.ln_ffn, modl, 6144, 8192, ACT, gw, NGW, lane);
                        else norm_phase<0, true>(XR, YB, XR, nullptr, P.ln_ffn + l * D, modl, 6144, 8192, ACT, gw, NGW, lane); } break;
        case 8: EN(8) { pg8::Gemm g{ACT, (const bf16_t*)(P.ws + WS_WGU) + (size_t)l * NGU * D, M, NGU, D}; pg8::StaticOrder S; S.init(M, NGU, G, (int)blockIdx.x);
            EpiSwiglu E{PROJ};
            pg8::gemm_phase<EpiSwiglu, pg8::StaticOrder, true, true>(lds, g, S, E, tid); } break;
        case 9: EN(9) { pg8::Gemm g{PROJ, (const bf16_t*)(P.ws + WS_WDN) + (size_t)l * D * FF, M, D, FF}; pg8::StaticOrder S; S.init(M, D, G, (int)blockIdx.x);
            EpiY E{YB, modl + 10240};
            pg8::gemm_phase<EpiY, pg8::StaticOrder, true, true>(lds, g, S, E, tid); } break;
        }
    }
}
}

extern "C" void kernel_launch(void* const* d_in, const int* in_sizes, int n_in, void* d_out, int out_size, void* d_ws, size_t ws_size, hipStream_t stream) {
    static int grid = 0;
    if (grid == 0) {
        if (n_in != 16 || out_size != mk::M * mk::D || ws_size < mk::WS_END) { fprintf(stderr, "kernel_launch: unexpected shapes (n_in %d, out %d, ws %zu)\n", n_in, out_size, ws_size); grid = -1; return; }
        int dev = 0, cus = 0, per_cu = 0;
        hipGetDevice(&dev); hipDeviceGetAttribute(&cus, hipDeviceAttributeMultiprocessorCount, dev);
        if (hipFuncSetAttribute((const void*)mk::fwd_kernel, hipFuncAttributeMaxDynamicSharedMemorySize, mk::LDS_BYTES) != hipSuccess) { fprintf(stderr, "kernel_launch: hipFuncSetAttribute failed\n"); grid = -1; return; }
        if (hipOccupancyMaxActiveBlocksPerMultiprocessor(&per_cu, (const void*)mk::fwd_kernel, 512, mk::LDS_BYTES) != hipSuccess || per_cu < 1) per_cu = 1;
        (void)hipGetLastError();
        grid = cus * per_cu;
        if (grid < 128) { fprintf(stderr, "kernel_launch: grid %d too small\n", grid); grid = -1; return; }
    }
    if (grid < 0) return;
    mk::Params p{};
    const float** f = (const float**)&p;
    for (int i = 0; i < 16; ++i) f[i] = (const float*)d_in[i];
    p.out = (float*)d_out; p.ws = (unsigned char*)d_ws;
#if ONE_LAUNCH
    p.ph_lo = 0; p.ph_hi = mk::N_PHASES;
    if (hipMemsetAsync((char*)d_ws + mk::WS_CTL, 0, 65536, stream) != hipSuccess) { fprintf(stderr, "kernel_launch: memset of the barrier words failed\n"); return; }
    void* args[] = {&p};
    hipError_t e = hipLaunchCooperativeKernel((const void*)mk::fwd_kernel, dim3(grid), dim3(512), args, mk::LDS_BYTES, stream);
    if (e != hipSuccess) fprintf(stderr, "cooperative launch failed: %s (grid %d)\n", hipGetErrorString(e), grid);
#else
    for (int ph = 0; ph < mk::N_PHASES; ++ph) { p.ph_lo = ph; p.ph_hi = ph + 1; hipLaunchKernelGGL(mk::fwd_kernel, dim3(grid), dim3(512), mk::LDS_BYTES, stream, p); }
#endif
}
```

```cpp
#include <hip/hip_runtime.h>
#include <hip/hip_cooperative_groups.h>
#include <cstdio>
#include <cstdint>
namespace cg = cooperative_groups;
#ifndef ONE_LAUNCH
#define ONE_LAUNCH 1
#endif
namespace pg8 {
#define PG8_LAS __attribute__((address_space(3)))
typedef unsigned short bf16_t;
typedef short bf16x8 __attribute__((ext_vector_type(8)));
typedef float f32x4 __attribute__((ext_vector_type(4)));
typedef unsigned u32x4 __attribute__((ext_vector_type(4)));
constexpr int BM = 256, BK = 64, HALF = 128, HTB = HALF * BK * 2  , STAGE_BYTES = 8 * HTB, NXCD = 8, WGM = 4;

__host__ __device__ __forceinline__ int lds_byte(int r, int c) { const int st = (r >> 4) * 2 + (c >> 5), rr = r & 15, cc = c & 31, ob = rr * 64 + cc * 2; return st * 1024 + (ob ^ (((ob >> 9) & 1) << 5)); }
__host__ __device__ __forceinline__ void stage_rc(int b, int& R, int& C) { const int st = b / 1024, sb = b % 1024, swz = sb ^ (((sb >> 9) & 1) << 5); R = (st >> 1) * 16 + swz / 64; C = (st & 1) * 32 + (swz % 64) / 2; }
__host__ __device__ __forceinline__ int perm32(int rho) { const int n = rho >> 4, i = rho & 15; return 8 * (i >> 2) + 4 * n + (i & 3); }

struct Unit { int pm, pn; };
struct Gemm { const bf16_t* A; const bf16_t* Bt; int M, N, K; };

struct StaticOrder {
    int nM, nN, nwg, G, c;
    __host__ __device__ void init(int M, int N, int G_, int c_) { nM = M / BM; nN = N / BM; nwg = nM * nN; G = G_; c = c_; }
    __host__ __device__ bool next(int i, Unit& u) const {
        const long L = (long)i * G + c; if (L >= nwg) return false;
        int wgid = (int)L; { const int q = nwg / NXCD, r = nwg % NXCD, xcd = wgid % NXCD, off = wgid / NXCD; wgid = (xcd < r ? xcd * (q + 1) : r * (q + 1) + (xcd - r) * q) + off; }
        const int nig = WGM * nN, gid = wgid / nig, fm = gid * WGM, gsz = (nM - fm) < WGM ? (nM - fm) : WGM;
        u.pm = fm + ((wgid % nig) % gsz); u.pn = (wgid % nig) / gsz; return true;
    }
    __device__ __forceinline__ void a_ready(const Unit&) const {}
    __device__ __forceinline__ void done(const Unit&) const {}
};

__device__ __forceinline__ unsigned cvt_pk_bf16(float lo, float hi) { unsigned r; asm volatile("v_cvt_pk_bf16_f32 %0, %1, %2" : "=v"(r) : "v"(lo), "v"(hi)); return r; }
template <class Epi, class Sched, bool ALIGN_EPI = false, bool SP2 = false>
__device__ __forceinline__ void gemm_phase(PG8_LAS unsigned char* lds, const Gemm g, const Sched& S, const Epi& E, const int tid_in) {
    const int tid = tid_in, wid = __builtin_amdgcn_readfirstlane(tid >> 6), lane = tid & 63, wr = wid >> 2, wc = wid & 3, fr = lane & 15, fq = lane >> 4;
    const int K = g.K, nt = K / BK;
    unsigned voffA[2], voffB[2];
#pragma unroll
    for (int i = 0; i < 2; ++i) { int R, C; stage_rc(tid * 16 + i * 8192, R, C); const int Rb = Epi::PERM ? ((R & ~31) + perm32(R & 31)) : R;
        voffA[i] = (unsigned)(R * K + C) * 2u; voffB[i] = (unsigned)(Rb * K + C) * 2u; }
    const size_t kstep = (size_t)(BK * 2);
    const size_t hstep = (size_t)HALF * K * 2;
    const size_t tstep = 2 * hstep;
    const unsigned ldsw = (unsigned)wid * 1024u;
    const int aoff = lds_byte(wr * 64 + fr, fq * 8), boff = lds_byte(wc * 32 + fr, fq * 8);
#define PG8_SA(b, h) (((b) * 2 + (h)) * HTB)
#define PG8_SB(b, h) ((4 + (b) * 2 + (h)) * HTB)
#define PG8_STAGE(bufoff, gbase, voff) do { _Pragma("unroll") for (int _i = 0; _i < 2; ++_i) \
        __builtin_amdgcn_global_load_lds((const unsigned*)((const char*)(gbase) + (voff)[_i]), (PG8_LAS unsigned*)(lds + (bufoff) + ldsw + _i * 8192), 16, 0, 0); } while (0)
#define PG8_LDA(dst, b, h) do { _Pragma("unroll") for (int m = 0; m < 4; ++m) _Pragma("unroll") for (int k = 0; k < 2; ++k) dst[m][k] = *(const PG8_LAS bf16x8*)(lds + PG8_SA(b, h) + aoff + m * 2048 + k * 1024); } while (0)
#define PG8_LDB(dst, b, h) do { _Pragma("unroll") for (int n = 0; n < 2; ++n) _Pragma("unroll") for (int k = 0; k < 2; ++k) dst[n][k] = *(const PG8_LAS bf16x8*)(lds + PG8_SB(b, h) + boff + n * 2048 + k * 1024); } while (0)
#define PG8_MMA(ai, bj, At, Bt) do { __builtin_amdgcn_s_setprio(1); _Pragma("unroll") for (int m = 0; m < 4; ++m) _Pragma("unroll") for (int n = 0; n < 2; ++n) _Pragma("unroll") for (int k = 0; k < 2; ++k) \
        acc[ai][bj][m][n] = __builtin_amdgcn_mfma_f32_16x16x32_bf16(Bt[n][k], At[m][k], acc[ai][bj][m][n], 0, 0, 0); __builtin_amdgcn_s_setprio(0); } while (0)
#define PG8_WAIT_V(n) asm volatile("s_waitcnt vmcnt(" #n ")" ::: "memory")
#define PG8_WAIT_L(n) asm volatile("s_waitcnt lgkmcnt(" #n ")" ::: "memory")
#define PG8_BAR __builtin_amdgcn_s_barrier()
#define PG8_SCHED __builtin_amdgcn_sched_barrier(0)
    Unit cur, nxt; int ui = 0;
    if (!S.next(0, cur)) return;
    f32x4 acc[2][2][4][2];
#pragma unroll
    for (int a = 0; a < 2; ++a)
#pragma unroll
        for (int b = 0; b < 2; ++b)
#pragma unroll
            for (int m = 0; m < 4; ++m)
#pragma unroll
                for (int n = 0; n < 2; ++n) acc[a][b][m][n] = (f32x4){0.f, 0.f, 0.f, 0.f};
    bf16x8 At[4][2], B0[2][2], B1[2][2];
    const char* cA = (const char*)g.A + (size_t)cur.pm * tstep; const char* cB = (const char*)g.Bt + (size_t)cur.pn * tstep;
    S.a_ready(cur);
    if constexpr (SP2) {
        PG8_STAGE(PG8_SB(0, 0), cB, voffB); PG8_STAGE(PG8_SB(0, 1), cB + hstep, voffB); PG8_STAGE(PG8_SA(0, 0), cA, voffA); PG8_STAGE(PG8_SA(0, 1), cA + hstep, voffA);
        if (wr == 1) PG8_BAR;
        PG8_WAIT_V(2); PG8_BAR;
        PG8_STAGE(PG8_SB(1, 0), cB + kstep, voffB); PG8_STAGE(PG8_SA(1, 0), cA + kstep, voffA); PG8_STAGE(PG8_SB(1, 1), cB + hstep + kstep, voffB);
        PG8_WAIT_V(6); PG8_BAR;
    } else {
        PG8_STAGE(PG8_SB(0, 0), cB, voffB); PG8_STAGE(PG8_SA(0, 0), cA, voffA); PG8_STAGE(PG8_SB(0, 1), cB + hstep, voffB); PG8_STAGE(PG8_SA(0, 1), cA + hstep, voffA);
        if (wr == 1) PG8_BAR;
        PG8_WAIT_V(4); PG8_BAR;
        PG8_STAGE(PG8_SB(1, 0), cB + kstep, voffB); PG8_STAGE(PG8_SA(1, 0), cA + kstep, voffA); PG8_STAGE(PG8_SB(1, 1), cB + hstep + kstep, voffB);
        PG8_WAIT_V(6); PG8_BAR;
    }
    for (;;) {
        const bool has_next = S.next(ui + 1, nxt);
        const char* nA = has_next ? (const char*)g.A + (size_t)nxt.pm * tstep : cA; const char* nB = has_next ? (const char*)g.Bt + (size_t)nxt.pn * tstep : cB;
        for (int t = 0; t < nt; t += 2) {
            const bool last = (t == nt - 2);
            const char* a1 = cA + (size_t)(t + 1) * kstep;
            const char* a2 = last ? nA : cA + (size_t)(t + 2) * kstep; const char* b2 = last ? nB : cB + (size_t)(t + 2) * kstep;
            const char* a3 = a2 + kstep; const char* b3 = b2 + kstep;
            if (last && has_next) S.a_ready(nxt);
            if constexpr (SP2) {
            PG8_LDB(B0, 0, 0); PG8_LDB(B1, 0, 1); PG8_SCHED; PG8_LDA(At, 0, 0); PG8_STAGE(PG8_SA(1, 1), a1 + hstep, voffA);
            PG8_WAIT_V(8); PG8_WAIT_L(0); PG8_BAR; PG8_MMA(0, 0, At, B0); PG8_MMA(0, 1, At, B1); PG8_BAR; PG8_SCHED;
            PG8_LDA(At, 0, 1); PG8_STAGE(PG8_SB(0, 0), b2, voffB); PG8_STAGE(PG8_SB(0, 1), b2 + hstep, voffB); PG8_STAGE(PG8_SA(0, 0), a2, voffA);
            PG8_WAIT_V(8); PG8_WAIT_L(0); PG8_BAR; PG8_MMA(1, 0, At, B0); PG8_MMA(1, 1, At, B1); PG8_BAR; PG8_SCHED;
            PG8_LDB(B0, 1, 0); PG8_LDB(B1, 1, 1); PG8_SCHED; PG8_LDA(At, 1, 0); PG8_STAGE(PG8_SA(0, 1), a2 + hstep, voffA);
            PG8_WAIT_V(8); PG8_WAIT_L(0); PG8_BAR; PG8_MMA(0, 0, At, B0); PG8_MMA(0, 1, At, B1); PG8_BAR; PG8_SCHED;
            PG8_LDA(At, 1, 1); PG8_STAGE(PG8_SB(1, 0), b3, voffB); PG8_STAGE(PG8_SB(1, 1), b3 + hstep, voffB); PG8_STAGE(PG8_SA(1, 0), a3, voffA);
            PG8_WAIT_V(8); PG8_WAIT_L(0); PG8_BAR; PG8_MMA(1, 0, At, B0); PG8_MMA(1, 1, At, B1); PG8_BAR; PG8_SCHED;
            } else {
            PG8_LDB(B0, 0, 0); PG8_SCHED; PG8_LDA(At, 0, 0); PG8_STAGE(PG8_SA(1, 1), a1 + hstep, voffA);
            PG8_WAIT_L(8); PG8_BAR; PG8_WAIT_L(0); PG8_MMA(0, 0, At, B0); PG8_BAR; PG8_SCHED;
            PG8_LDB(B1, 0, 1); PG8_STAGE(PG8_SB(0, 0), b2, voffB);
            PG8_BAR; PG8_WAIT_L(0); PG8_MMA(0, 1, At, B1); PG8_BAR;
            PG8_LDA(At, 0, 1); PG8_STAGE(PG8_SA(0, 0), a2, voffA);
            PG8_BAR; PG8_WAIT_L(0); PG8_MMA(1, 0, At, B0); PG8_BAR; PG8_SCHED;
            PG8_STAGE(PG8_SB(0, 1), b2 + hstep, voffB);
            PG8_WAIT_V(6); PG8_BAR; PG8_MMA(1, 1, At, B1); PG8_BAR;
            PG8_LDB(B0, 1, 0); PG8_SCHED; PG8_LDA(At, 1, 0); PG8_STAGE(PG8_SA(0, 1), a2 + hstep, voffA);
            PG8_WAIT_L(8); PG8_BAR; PG8_WAIT_L(0); PG8_MMA(0, 0, At, B0); PG8_BAR; PG8_SCHED;
            PG8_LDB(B1, 1, 1); PG8_STAGE(PG8_SB(1, 0), b3, voffB);
            PG8_BAR; PG8_WAIT_L(0); PG8_MMA(0, 1, At, B1); PG8_BAR;
            PG8_LDA(At, 1, 1); PG8_STAGE(PG8_SA(1, 0), a3, voffA);
            PG8_BAR; PG8_WAIT_L(0); PG8_MMA(1, 0, At, B0); PG8_BAR; PG8_SCHED;
            PG8_STAGE(PG8_SB(1, 1), b3 + hstep, voffB);
            PG8_WAIT_V(6); PG8_BAR; PG8_MMA(1, 1, At, B1); PG8_BAR;
            }
        }
        if constexpr (ALIGN_EPI) { if (wr == 0) PG8_BAR; }
        if constexpr (!Epi::AFTER_DRAIN) { E(acc, cur, wr, wc, fr, fq); S.done(cur); }
        if (!has_next) break;
#pragma unroll
        for (int a = 0; a < 2; ++a)
#pragma unroll
            for (int b = 0; b < 2; ++b)
#pragma unroll
                for (int m = 0; m < 4; ++m)
#pragma unroll
                    for (int n = 0; n < 2; ++n) acc[a][b][m][n] = (f32x4){0.f, 0.f, 0.f, 0.f};
        cur = nxt; cA = nA; cB = nB; ++ui;
        if constexpr (ALIGN_EPI) { if (wr == 1) PG8_BAR; }
    }
    PG8_WAIT_V(0);
    if constexpr (!ALIGN_EPI) { if (wr == 0) PG8_BAR; }
    PG8_BAR;
    if constexpr (Epi::AFTER_DRAIN) { E.fused(acc, cur, wr, wc, fr, fq, lds, wid, lane); S.done(cur); }
#undef PG8_SA
#undef PG8_SB
#undef PG8_STAGE
#undef PG8_LDA
#undef PG8_LDB
#undef PG8_MMA
#undef PG8_WAIT_V
#undef PG8_WAIT_L
#undef PG8_BAR
#undef PG8_SCHED
}
}

namespace mk {
#define LAS __attribute__((address_space(3)))
#define DI __device__ __forceinline__
typedef unsigned short bf16_t;
typedef short bf16x8 __attribute__((ext_vector_type(8)));
typedef float f32x4 __attribute__((ext_vector_type(4)));
typedef float f32x2 __attribute__((ext_vector_type(2)));
typedef float f32x16 __attribute__((ext_vector_type(16)));
typedef unsigned u32x4 __attribute__((ext_vector_type(4)));
typedef unsigned u32x2 __attribute__((ext_vector_type(2)));
typedef __bf16 bf16x2_t __attribute__((ext_vector_type(2)));
#define MFMA32(a, b, c) __builtin_amdgcn_mfma_f32_32x32x16_bf16((a), (b), (c), 0, 0, 0)

constexpr int T = 8192, M = 16384, D = 2048, DEPTH = 2;
constexpr int NPROJ = 5632, FF = 5632, NGU = 11264, INC = 5392, NMOD = 12288;
constexpr int C_Z = 3072, C_Q = 4096, C_K = 5120, C_V = 5248, C_BA = 5376;
constexpr float EPS = 1e-6f;
constexpr size_t MiB = (size_t)1 << 20;
constexpr size_t WS_CTL = 0;
constexpr size_t WS_WIN = 1 * MiB;
constexpr size_t WS_WOUT = WS_WIN + 44 * MiB;
constexpr size_t WS_WGU = WS_WOUT + 16 * MiB;
constexpr size_t WS_WDN = WS_WGU + 88 * MiB;
constexpr size_t WS_ACT = WS_WDN + 44 * MiB;
constexpr size_t WS_PROJ = WS_ACT + 64 * MiB;
constexpr size_t WS_QN = WS_PROJ + 176 * MiB;
constexpr size_t WS_KN = WS_QN + 32 * MiB;
constexpr size_t WS_VN = WS_KN + 32 * MiB;
constexpr size_t WS_ODN = WS_QN;
constexpr size_t WS_NW = WS_VN + 32 * MiB;
constexpr size_t WS_QG = WS_NW + 32 * MiB;
constexpr size_t WS_KD = WS_QG + 32 * MiB;
constexpr size_t WS_UF = WS_KD + 32 * MiB;
constexpr size_t WS_IN = WS_UF + 32 * MiB;
constexpr size_t WS_BA = WS_IN + 16 * MiB;
constexpr size_t WS_MODP = WS_BA + 1 * MiB;
constexpr size_t WS_MOD = WS_MODP + 3 * MiB;
constexpr size_t WS_ROPE = WS_MOD + 1 * MiB;
constexpr size_t WS_GL = WS_ROPE + 2 * MiB;
constexpr size_t WS_XR = WS_GL + 1 * MiB;
constexpr size_t WS_END = WS_XR + 64 * MiB;
static_assert(WS_END <= 768 * MiB, "d_ws map");

constexpr int LDS_BYTES = 155648;
constexpr int D3_SLOT = 61440;

struct Params {
    const float *x, *c, *ln_mix, *ln_ffn, *w_ada, *b_ada, *w_in, *conv_w, *a_log, *dt_bias, *norm_w, *sinks, *w_out, *w_gu, *w_dn, *ln_final;
    float* out; unsigned char* ws; int ph_lo, ph_hi;
};

DI unsigned cvtpk(float lo, float hi) { f32x2 v = {lo, hi}; bf16x2_t b = __builtin_convertvector(v, bf16x2_t); return __builtin_bit_cast(unsigned, b); }
DI void fnma_(float& a, float n, float w) { asm("v_fma_f32 %0, -%1, %2, %0" : "+v"(a) : "v"(n), "v"(w)); }
DI void fma_(float& a, float n, float w) { asm("v_fma_f32 %0, %1, %2, %0" : "+v"(a) : "v"(n), "v"(w)); }
DI unsigned bf1(float x) { return cvtpk(x, 0.f) & 0xffffu; }
DI float bflo(unsigned u) { return __uint_as_float(u << 16); }
DI float bfhi(unsigned u) { return __uint_as_float(u & 0xffff0000u); }
DI float wave_sum(float v) {
#pragma unroll
    for (int o = 1; o < 64; o <<= 1) v += __shfl_xor(v, o);
    return v;
}
DI float silu(float x) { return x * __builtin_amdgcn_rcpf(1.f + __expf(-x)); }
DI int crow(int i, int hi) { return (i & 3) + 8 * (i >> 2) + 4 * hi; }
DI int krow(int hi, int e) { return 8 * (e >> 2) + 4 * hi + (e & 3); }
DI int swap23(int p) { return (p & ~12) | ((p & 4) << 1) | ((p & 8) >> 1); }
DI void wave_lds_fence() { __builtin_amdgcn_fence(__ATOMIC_RELEASE, "wavefront"); __builtin_amdgcn_wave_barrier(); __builtin_amdgcn_fence(__ATOMIC_ACQUIRE, "wavefront"); }

DI int map_in(int c) {
    if (c < 4096) return c;
    if (c < 4112) return C_BA + (c - 4096);
    const int cp = c - 16;
    if (cp < C_V) { const int d = cp & 63, base = cp & ~63; return base + ((d < 32) ? 2 * d : 2 * (d - 32) + 1); }
    return cp;
}
DI int map_gu(int c) { const int up = c >= FF ? 1 : 0; const int j = up ? c - FF : c; return 256 * (j >> 7) + 128 * up + (j & 127); }
template <int MODE> DI void transpose_item(const float* __restrict__ W, int K, int N, bf16_t* WT, LAS float* scr, int item, int lane) {
    const int nblk = (N + 31) / 32, kb = item / nblk, nb = item % nblk, k0 = 64 * kb, n0 = 32 * nb;
    const int ncol = n0 + (lane & 31); const bool okc = ncol < N;
    float tv[32];
#pragma unroll
    for (int i = 0; i < 32; ++i) { const int kk = 2 * i + (lane >> 5); tv[i] = okc ? W[(size_t)(k0 + kk) * N + ncol] : 0.f; }
#pragma unroll
    for (int i = 0; i < 32; ++i) { const int kk = 2 * i + (lane >> 5); scr[kk * 33 + (lane & 31)] = tv[i]; }
    wave_lds_fence();
    const int c = lane & 7;
#pragma unroll
    for (int j = 0; j < 4; ++j) { const int n = (lane >> 3) + 8 * j; const LAS float* s = scr + (8 * c) * 33 + n;
        u32x4 o; o.x = cvtpk(s[0 * 33], s[1 * 33]); o.y = cvtpk(s[2 * 33], s[3 * 33]); o.z = cvtpk(s[4 * 33], s[5 * 33]); o.w = cvtpk(s[6 * 33], s[7 * 33]);
        const int nsrc = n0 + n;
        if (nsrc < N) { const int nd = MODE == 1 ? map_in(nsrc) : (MODE == 2 ? map_gu(nsrc) : nsrc); *(u32x4*)(WT + (size_t)nd * K + k0 + 8 * c) = o; } }
    wave_lds_fence();
}

constexpr int I_IN = 32 * 169, I_OUT = 32 * 64, I_GU = 32 * 352, I_DN = 88 * 64, I_L = I_IN + I_OUT + I_GU + I_DN;
DI void convert_items(const Params& P, LAS unsigned char* lds, int it0, int it1, int gw, int NGW, int wave, int lane) {
    LAS float* scr = (LAS float*)(lds + wave * 16384);
    bf16_t* WIN = (bf16_t*)(P.ws + WS_WIN); bf16_t* WOUT = (bf16_t*)(P.ws + WS_WOUT); bf16_t* WGU = (bf16_t*)(P.ws + WS_WGU); bf16_t* WDN = (bf16_t*)(P.ws + WS_WDN);
    for (int it = it0 + gw; it < it1; it += NGW) {
        const int l = it / I_L; int r = it % I_L;
        if (r < I_IN) { transpose_item<1>(P.w_in + (size_t)l * D * INC, D, INC, WIN + (size_t)l * NPROJ * D, scr, r, lane); continue; } r -= I_IN;
        if (r < I_OUT) { transpose_item<0>(P.w_out + (size_t)l * D * D, D, D, WOUT + (size_t)l * D * D, scr, r, lane); continue; } r -= I_OUT;
        if (r < I_GU) { transpose_item<2>(P.w_gu + (size_t)l * D * NGU, D, NGU, WGU + (size_t)l * NGU * D, scr, r, lane); continue; } r -= I_GU;
        transpose_item<0>(P.w_dn + (size_t)l * FF * D, FF, D, WDN + (size_t)l * D * FF, scr, r, lane);
    }
}
DI void p0_phase(const Params& P, LAS unsigned char* lds, int gw, int NGW, int wave, int lane) {
    bf16_t* WIN = (bf16_t*)(P.ws + WS_WIN);
    convert_items(P, lds, 0, I_IN, gw, NGW, wave, lane);
    const int gt = gw * 64 + lane, NGT = NGW * 64;
    for (int i = gt; i < 2 * 240 * 256; i += NGT) { const int l = i / (240 * 256), q = i % (240 * 256);
        *(u32x4*)(WIN + (size_t)l * NPROJ * D + (size_t)INC * D + (size_t)q * 8) = (u32x4){0u, 0u, 0u, 0u}; }
    float* ROPE = (float*)(P.ws + WS_ROPE);
    for (int i = gt; i < T * 32; i += NGT) { const int t = i >> 5, fi = i & 31;
        double f = 1.0; for (int q = 0; q < fi; ++q) f *= 0.7498942093324558;
        const float ang_f = (float)t * (float)f;
        const double ang = (double)ang_f, n = rint(ang * 0.15915494309189535), rr = (ang - n * 6.2831853071795862) - n * 2.4492935982947064e-16, r2 = rr * rr;
        double cs = 1.0, sn = rr, tc = 1.0, ts = rr;
#pragma unroll
        for (int q = 1; q <= 14; ++q) { tc *= -r2 * (1.0 / (double)((2 * q - 1) * (2 * q))); ts *= -r2 * (1.0 / (double)((2 * q) * (2 * q + 1))); cs += tc; sn += ts; }
        *(f32x2*)(ROPE + 2 * (size_t)i) = (f32x2){(float)cs, (float)sn}; }
    float* MODP = (float*)(P.ws + WS_MODP);
    for (int it = gw; it < 2 * 16 * 48; it += NGW) {
        const int cgp = it % 48, kc = (it / 48) % 16, l = it / 768, j0 = cgp * 256 + 4 * lane;
        f32x4 a0 = {0.f, 0.f, 0.f, 0.f}, a1 = {0.f, 0.f, 0.f, 0.f};
        const float* wp = P.w_ada + ((size_t)l * D + kc * 128) * NMOD + j0;
#pragma unroll 8
        for (int k = 0; k < 128; ++k) { const f32x4 w4 = *(const f32x4*)(wp + (size_t)k * NMOD);
            const float c0 = silu(P.c[kc * 128 + k]), c1 = silu(P.c[D + kc * 128 + k]); a0 += w4 * c0; a1 += w4 * c1; }
        *(f32x4*)(MODP + ((size_t)(kc * 2 + l) * 2 + 0) * NMOD + j0) = a0;
        *(f32x4*)(MODP + ((size_t)(kc * 2 + l) * 2 + 1) * NMOD + j0) = a1;
    }
}
DI void mod_phase(const Params& P, int gw, int NGW, int lane) {
    const float* MODP = (const float*)(P.ws + WS_MODP); float* MOD = (float*)(P.ws + WS_MOD);
    for (int i = gw * 64 + lane; i < 2 * 2 * NMOD; i += NGW * 64) { const int l = i / (2 * NMOD), j = i % NMOD;
        float s = P.b_ada[l * NMOD + j];
#pragma unroll
        for (int kc = 0; kc < 16; ++kc) s += MODP[(size_t)kc * (4 * NMOD) + i];
        MOD[i] = s; }
}

template <int MODE, bool XBF> DI void norm_phase(const void* Xv, const bf16_t* Y, bf16_t* xr_out, float* xout, const float* __restrict__ lnw, const float* __restrict__ modl  , int sh_off, int sc_off, bf16_t* out_bf, int gw, int NGW, int lane) {
    typedef __attribute__((address_space(1))) const f32x4* gcp; typedef __attribute__((address_space(1))) const u32x2* gcy;
    const int rows_per = (M + NGW - 1) / NGW; const int m0 = gw * rows_per, m1 = (m0 + rows_per < M) ? m0 + rows_per : M;
    if (m0 >= m1) return;
    f32x4 A[8], B[8]; int curb = -1;
    f32x4 v[8], vn[8]; u32x2 yv[8], yn[8], xb[8], xbn[8];
#define NP_LOAD(V, XB, YV, ROW) do { _Pragma("unroll") for (int j = 0; j < 8; ++j) { \
        if (XBF) XB[j] = ((gcy)((const bf16_t*)Xv + (size_t)(ROW) * D) + lane)[64 * j]; else V[j] = ((gcp)((const float*)Xv + (size_t)(ROW) * D) + lane)[64 * j]; \
        if (Y) YV[j] = ((gcy)(Y + (size_t)(ROW) * D) + lane)[64 * j]; } } while (0)
#pragma unroll
    for (int j = 0; j < 8; ++j) { v[j] = (f32x4){0.f, 0.f, 0.f, 0.f}; vn[j] = v[j]; yv[j] = (u32x2){0u, 0u}; yn[j] = yv[j]; xb[j] = yv[j]; xbn[j] = yv[j]; }
    NP_LOAD(v, xb, yv, m0);
    for (int m = m0; m < m1; ++m) {
        const int b = m / T;
        if (b != curb) { curb = b;
#pragma unroll
            for (int j = 0; j < 8; ++j) { const int k = 4 * (lane + 64 * j); const f32x4 g = *(const f32x4*)(lnw + k);
                if (MODE == 0) { const f32x4 sc = *(const f32x4*)(modl + b * NMOD + sc_off + k); A[j] = g * (sc + 1.0f); B[j] = *(const f32x4*)(modl + b * NMOD + sh_off + k); } else { A[j] = g; B[j] = (f32x4){0.f, 0.f, 0.f, 0.f}; } } }
        if (m + 1 < m1) NP_LOAD(vn, xbn, yn, m + 1);
        float s = 0.f;
#pragma unroll
        for (int j = 0; j < 8; ++j) { if (XBF) v[j] = (f32x4){bflo(xb[j].x), bfhi(xb[j].x), bflo(xb[j].y), bfhi(xb[j].y)};
            if (Y) { v[j].x += bflo(yv[j].x); v[j].y += bfhi(yv[j].x); v[j].z += bflo(yv[j].y); v[j].w += bfhi(yv[j].y); }
            s += (v[j].x * v[j].x + v[j].y * v[j].y) + (v[j].z * v[j].z + v[j].w * v[j].w); }
        const float rstd = 1.0f / sqrtf(wave_sum(s) * (1.0f / D) + EPS);
        if (MODE == 0) {
            if (xr_out) { u32x2* xo = (u32x2*)(xr_out + (size_t)m * D) + lane;
#pragma unroll
                for (int j = 0; j < 8; ++j) { u32x2 w; w.x = cvtpk(v[j].x, v[j].y); w.y = cvtpk(v[j].z, v[j].w); xo[64 * j] = w; } }
            u32x2* o = (u32x2*)(out_bf + (size_t)m * D) + lane;
#pragma unroll
            for (int j = 0; j < 8; ++j) { const f32x4 y = v[j] * rstd * A[j] + B[j]; u32x2 w; w.x = cvtpk(y.x, y.y); w.y = cvtpk(y.z, y.w); o[64 * j] = w; }
        } else { f32x4* xo = (f32x4*)(xout + (size_t)m * D) + lane;
#pragma unroll
            for (int j = 0; j < 8; ++j) xo[64 * j] = v[j] * rstd * A[j]; }
#pragma unroll
        for (int j = 0; j < 8; ++j) { v[j] = vn[j]; yv[j] = yn[j]; xb[j] = xbn[j]; }
    }
#undef NP_LOAD
}

struct EpiIn {
    static constexpr bool PERM = true, AFTER_DRAIN = false;
    bf16_t* O; float* BA; const float* rope;
    DI void operator()(const pg8::f32x4 (&acc)[2][2][4][2], const pg8::Unit& u, int wr, int wc, int fr, int fq) const {
        const int row0 = u.pm * 256 + wr * 64 + fr, col0 = u.pn * 256 + wc * 32 + 8 * fq;
        typedef __attribute__((address_space(1))) const f32x4* gcp;
        const bool any_rope = (u.pn >= 16 && u.pn <= 20);
#pragma unroll
        for (int ai = 0; ai < 2; ++ai) {
            f32x4 rp[4][2][2];
            if (any_rope) {
#pragma unroll
                for (int m = 0; m < 4; ++m) { const int t = (row0 + ai * 128 + m * 16) & (T - 1);
#pragma unroll
                    for (int bj = 0; bj < 2; ++bj) { const int i0 = ((col0 + bj * 128) & 63) >> 1;
                        rp[m][bj][0] = *(gcp)(rope + ((size_t)t * 32 + i0) * 2); rp[m][bj][1] = *(gcp)(rope + ((size_t)t * 32 + i0 + 2) * 2); } } }
#pragma unroll
            for (int m = 0; m < 4; ++m) { const int row = row0 + ai * 128 + m * 16; bf16_t* rowp = O + (size_t)row * NPROJ + col0;
#pragma unroll
                for (int bj = 0; bj < 2; ++bj) { f32x4 v0 = acc[ai][bj][m][0], v1 = acc[ai][bj][m][1];
                    const bool is_q = (u.pn >= 16 && u.pn < 20), is_k = (u.pn == 20 && bj == 0);
                    if (is_q || is_k) {
                        const f32x4 r0 = rp[m][bj][0], r1 = rp[m][bj][1];
                        const float sc = is_q ? 0.125f : 1.0f;
                        f32x4 w0, w1;
                        w0.x = (v0.x * r0.x - v0.y * r0.y) * sc; w0.y = (v0.y * r0.x + v0.x * r0.y) * sc; w0.z = (v0.z * r0.z - v0.w * r0.w) * sc; w0.w = (v0.w * r0.z + v0.z * r0.w) * sc;
                        w1.x = (v1.x * r1.x - v1.y * r1.y) * sc; w1.y = (v1.y * r1.x + v1.x * r1.y) * sc; w1.z = (v1.z * r1.z - v1.w * r1.w) * sc; w1.w = (v1.w * r1.z + v1.z * r1.w) * sc;
                        v0 = w0; v1 = w1;
                    }
                    if (u.pn == 21) { if (bj == 0 && wc == 0 && fq < 2) { *(f32x4*)(BA + (size_t)row * 16 + 8 * fq) = v0; *(f32x4*)(BA + (size_t)row * 16 + 8 * fq + 4) = v1; } }
                    else { u32x4 w; w.x = cvtpk(v0.x, v0.y); w.y = cvtpk(v0.z, v0.w); w.z = cvtpk(v1.x, v1.y); w.w = cvtpk(v1.z, v1.w); *(u32x4*)(rowp + bj * 128) = w; } } }
        }
    }
};
struct EpiY {
    static constexpr bool PERM = true, AFTER_DRAIN = false;
    bf16_t* Y; const float* gate  ;
    DI void operator()(const pg8::f32x4 (&acc)[2][2][4][2], const pg8::Unit& u, int wr, int wc, int fr, int fq) const {
        const int row0 = u.pm * 256 + wr * 64 + fr, col0 = u.pn * 256 + wc * 32 + 8 * fq; const int b = (u.pm * 256) / T;
        f32x4 g[2][2];
#pragma unroll
        for (int bj = 0; bj < 2; ++bj)
#pragma unroll
            for (int n = 0; n < 2; ++n) g[bj][n] = *(const f32x4*)(gate + b * NMOD + col0 + bj * 128 + n * 4);
#pragma unroll
        for (int ai = 0; ai < 2; ++ai)
#pragma unroll
            for (int m = 0; m < 4; ++m) { bf16_t* rowp = Y + (size_t)(row0 + ai * 128 + m * 16) * D + col0;
#pragma unroll
                for (int bj = 0; bj < 2; ++bj) { const f32x4 v0 = acc[ai][bj][m][0] * g[bj][0], v1 = acc[ai][bj][m][1] * g[bj][1];
                    u32x4 w; w.x = cvtpk(v0.x, v0.y); w.y = cvtpk(v0.z, v0.w); w.z = cvtpk(v1.x, v1.y); w.w = cvtpk(v1.z, v1.w); *(u32x4*)(rowp + bj * 128) = w; } }
    }
};
struct EpiSwiglu {
    static constexpr bool PERM = true, AFTER_DRAIN = false;
    bf16_t* H;
    DI void operator()(const pg8::f32x4 (&acc)[2][2][4][2], const pg8::Unit& u, int wr, int wc, int fr, int fq) const {
        const int row0 = u.pm * 256 + wr * 64 + fr, col0 = u.pn * 128 + wc * 32 + 8 * fq;
#pragma unroll
        for (int ai = 0; ai < 2; ++ai)
#pragma unroll
            for (int m = 0; m < 4; ++m) { const f32x4 g0 = acc[ai][0][m][0], g1 = acc[ai][0][m][1], u0 = acc[ai][1][m][0], u1 = acc[ai][1][m][1];
                u32x4 w; w.x = cvtpk(silu(g0.x) * u0.x, silu(g0.y) * u0.y); w.y = cvtpk(silu(g0.z) * u0.z, silu(g0.w) * u0.w);
                w.z = cvtpk(silu(g1.x) * u1.x, silu(g1.y) * u1.y); w.w = cvtpk(silu(g1.z) * u1.z, silu(g1.w) * u1.w);
                *(u32x4*)(H + (size_t)(row0 + ai * 128 + m * 16) * FF + col0) = w; }
    }
};

DI void d1_phase(const Params& P, int l, int gw, int NGW, int lane) {
    typedef __attribute__((address_space(1))) const u32x4* gcu;
    const bf16_t* PROJ = (const bf16_t*)(P.ws + WS_PROJ); const float* cwp = P.conv_w + (size_t)l * 4 * 3072;
    constexpr int NIT = 1024 * 6;
#define D1_LOAD(RH, RV, IT) do { const int it_ = (IT); const int s_ = it_ % 6, m0_ = (it_ / 6) * 16, ch_ = 512 * s_ + 8 * lane; \
        _Pragma("unroll") for (int tt = 0; tt < 16; ++tt) RV[tt] = *(gcu)(PROJ + (size_t)(m0_ + tt) * NPROJ + ch_); } while (0)
#define D1_COMPUTE(RH, RV, IT) do { const int it_ = (IT); const int s_ = it_ % 6, m0 = (it_ / 6) * 16, b = m0 / T, t0 = m0 % T; \
        const int ch = 512 * s_ + 8 * lane, part = ch >> 10, h = (ch >> 7) & 7, d0 = ch & 127; \
        float cw[4][8]; \
        _Pragma("unroll") for (int j = 0; j < 4; ++j) { const f32x4 a = *(const f32x4*)(cwp + j * 3072 + ch), c2 = *(const f32x4*)(cwp + j * 3072 + ch + 4); \
            cw[j][0] = a.x; cw[j][1] = a.y; cw[j][2] = a.z; cw[j][3] = a.w; cw[j][4] = c2.x; cw[j][5] = c2.y; cw[j][6] = c2.z; cw[j][7] = c2.w; } \
        float xw[3][8]; \
        _Pragma("unroll") for (int j = 0; j < 3; ++j) { u32x4 raw = {0u, 0u, 0u, 0u}; if (t0 > 0) raw = *(gcu)(PROJ + (size_t)(m0 - 3 + j) * NPROJ + ch); \
            xw[j][0] = bflo(raw.x); xw[j][1] = bfhi(raw.x); xw[j][2] = bflo(raw.y); xw[j][3] = bfhi(raw.y); xw[j][4] = bflo(raw.z); xw[j][5] = bfhi(raw.z); xw[j][6] = bflo(raw.w); xw[j][7] = bfhi(raw.w); } \
        bf16_t* dst = (bf16_t*)(P.ws + (part == 0 ? WS_QN : (part == 1 ? WS_KN : WS_VN))) + ((size_t)(b * 8 + h) * T + t0) * 128 + d0; \
        _Pragma("unroll") for (int tt = 0; tt < 16; ++tt) { \
            const u32x4 raw = RV[tt]; \
            float xc[8] = {bflo(raw.x), bfhi(raw.x), bflo(raw.y), bfhi(raw.y), bflo(raw.z), bfhi(raw.z), bflo(raw.w), bfhi(raw.w)}; \
            float y[8]; float ss = 0.f; \
            _Pragma("unroll") for (int e = 0; e < 8; ++e) { const float a = cw[0][e] * xw[0][e] + cw[1][e] * xw[1][e] + cw[2][e] * xw[2][e] + cw[3][e] * xc[e]; y[e] = silu(a); ss += y[e] * y[e]; \
                xw[0][e] = xw[1][e]; xw[1][e] = xw[2][e]; xw[2][e] = xc[e]; } \
            float scale = 1.0f; \
            if (part < 2) { ss += __shfl_xor(ss, 1); ss += __shfl_xor(ss, 2); ss += __shfl_xor(ss, 4); ss += __shfl_xor(ss, 8); \
                scale = __builtin_amdgcn_rsqf(ss + EPS) * (part == 0 ? 0.08838834764831845f : 1.0f); } \
            u32x4 w; w.x = cvtpk(y[0] * scale, y[1] * scale); w.y = cvtpk(y[2] * scale, y[3] * scale); w.z = cvtpk(y[4] * scale, y[5] * scale); w.w = cvtpk(y[6] * scale, y[7] * scale); \
            *(u32x4*)(dst + (size_t)tt * 128) = w; } } while (0)
    u32x4 vA[16], vB[16]; int hA = 0, hB = 0; (void)hA; (void)hB;
    if (gw < NIT) D1_LOAD(hA, vA, gw);
#pragma unroll 1
    for (int it = gw; it < NIT; it += 2 * NGW) {
        if (it + NGW < NIT) D1_LOAD(hB, vB, it + NGW);
        D1_COMPUTE(hA, vA, it);
        if (it + NGW < NIT) {
            if (it + 2 * NGW < NIT) D1_LOAD(hA, vA, it + 2 * NGW);
            D1_COMPUTE(hB, vB, it + NGW);
        }
    }
#undef D1_LOAD
#undef D1_COMPUTE
}

DI bf16x8 pack8(const f32x16& x, int g) {
    u32x4 p; p.x = cvtpk(x[8 * g + 0], x[8 * g + 1]); p.y = cvtpk(x[8 * g + 2], x[8 * g + 3]); p.z = cvtpk(x[8 * g + 4], x[8 * g + 5]); p.w = cvtpk(x[8 * g + 6], x[8 * g + 7]);
    return __builtin_bit_cast(bf16x8, p);
}
constexpr int NMS = 68;
DI void d2_chunk(const Params& P, int l, int chunk, LAS float* Nm, LAS float* gs, int lane_in) {
    int lane = lane_in; asm volatile("" : "+v"(lane));
    const int bh = chunk >> 7, n = chunk & 127, b = bh >> 3, h = bh & 7, r = lane & 31, hi = lane >> 5;
    const float* BA = (const float*)(P.ws + WS_BA);
    const bf16_t* Kc = (const bf16_t*)(P.ws + WS_KN) + ((size_t)bh * T + n * 64) * 128;
    const bf16_t* Qc = (const bf16_t*)(P.ws + WS_QN) + ((size_t)bh * T + n * 64) * 128;
    const bf16_t* Vc = (const bf16_t*)(P.ws + WS_VN) + ((size_t)bh * T + n * 64) * 128;
    bf16_t* NWf = (bf16_t*)(P.ws + WS_NW) + (size_t)chunk * 8192; bf16_t* QGf = (bf16_t*)(P.ws + WS_QG) + (size_t)chunk * 8192;
    bf16_t* KDf = (bf16_t*)(P.ws + WS_KD) + (size_t)chunk * 8192; bf16_t* INf = (bf16_t*)(P.ws + WS_IN) + (size_t)chunk * 4096;
    bf16_t* UF = (bf16_t*)(P.ws + WS_UF) + (size_t)chunk * 8192;
    {
        const int m = b * T + n * 64 + lane;
        const float braw = BA[(size_t)m * 16 + h], araw = BA[(size_t)m * 16 + 8 + h];
        const float beta = 1.0f / (1.0f + expf(-braw));
        const float xs = araw + P.dt_bias[l * 8 + h]; const float sp = xs > 20.f ? xs : log1pf(expf(xs));
        float gc = -expf(P.a_log[l * 8 + h]) * sp;
#pragma unroll
        for (int o = 1; o < 64; o <<= 1) { const float tv = __shfl_up(gc, o); if (lane >= o) gc += tv; }
        gs[lane] = gc; gs[64 + lane] = beta; gs[128 + lane] = -beta * __expf(gc);
    }
    wave_lds_fence();
    const float gcl = gs[63];
    {
        f32x16 kk00, kk10, kk11, qk00, qk10, qk11;
#pragma unroll
        for (int i = 0; i < 16; ++i) { kk00[i] = 0.f; kk10[i] = 0.f; kk11[i] = 0.f; qk00[i] = 0.f; qk10[i] = 0.f; qk11[i] = 0.f; }
#pragma unroll 2
        for (int kk = 0; kk < 8; ++kk) {
            const bf16x8 k0 = *(const bf16x8*)(Kc + r * 128 + 16 * kk + 8 * hi), k1 = *(const bf16x8*)(Kc + (32 + r) * 128 + 16 * kk + 8 * hi);
            const bf16x8 q0 = *(const bf16x8*)(Qc + r * 128 + 16 * kk + 8 * hi), q1 = *(const bf16x8*)(Qc + (32 + r) * 128 + 16 * kk + 8 * hi);
            kk00 = MFMA32(k0, k0, kk00); kk10 = MFMA32(k0, k1, kk10); kk11 = MFMA32(k1, k1, kk11);
            qk00 = MFMA32(k0, q0, qk00); qk10 = MFMA32(k0, q1, qk10); qk11 = MFMA32(k1, q1, qk11);
        }
#define D2_TILE(KKT, QKT, tc, ts) do { const int cc = 32 * (tc) + r; const float gcc = gs[cc], bcc = gs[64 + cc]; \
            _Pragma("unroll") for (int i = 0; i < 16; ++i) { const int s = 32 * (ts) + crow(i, hi); \
                const float dec = (s <= cc) ? __expf(gcc - gs[s]) : 0.f; \
                Nm[cc * NMS + s] = (s < cc) ? bcc * KKT[i] * dec : 0.f; QKT[i] *= dec; } \
            *(bf16x8*)(INf + (((tc) * 4 + 2 * (ts)) * 64 + lane) * 8) = pack8(QKT, 0); *(bf16x8*)(INf + (((tc) * 4 + 2 * (ts) + 1) * 64 + lane) * 8) = pack8(QKT, 1); } while (0)
        D2_TILE(kk00, qk00, 0, 0); D2_TILE(kk10, qk10, 1, 0); D2_TILE(kk11, qk11, 1, 1);
#undef D2_TILE
        *(u32x4*)(INf + ((0 * 4 + 2) * 64 + lane) * 8) = (u32x4){0u, 0u, 0u, 0u};
        *(u32x4*)(INf + ((0 * 4 + 3) * 64 + lane) * 8) = (u32x4){0u, 0u, 0u, 0u};
    }
    wave_lds_fence();
    __builtin_amdgcn_sched_barrier(0); asm volatile("" ::: "memory");
    {
        float t[64];
#define D2_TBLOCK(ib) do { \
            _Pragma("unroll") for (int ii = 0; ii < 16; ++ii) { const int i = 16 * (ib) + ii; float a = (i == lane) ? 1.f : 0.f; \
                _Pragma("unroll") for (int jb = 0; jb <= (ib); ++jb) { if (16 * jb < i) { \
                    _Pragma("unroll") for (int jj = 0; jj < 16; ++jj) { const int j = 16 * jb + jj; if (j < i) fnma_(a, Nm[i * NMS + j], t[j]); } \
                    __builtin_amdgcn_sched_barrier(0); } } \
                t[i] = a; Nm[i * NMS + lane] = a; } } while (0)
        D2_TBLOCK(0); D2_TBLOCK(1); D2_TBLOCK(2); D2_TBLOCK(3);
#undef D2_TBLOCK
    }
    wave_lds_fence();
    __builtin_amdgcn_sched_barrier(0); asm volatile("" ::: "memory");
    {
        bf16x8 Tfw[2][4], Tfu[2][4];
#pragma unroll
        for (int ct = 0; ct < 2; ++ct)
#pragma unroll
            for (int ks = 0; ks < 4; ++ks) { const LAS f32x4* tp = (const LAS f32x4*)(Nm + (32 * ct + r) * NMS + 16 * ks + 8 * hi); const f32x4 a = tp[0], c2 = tp[1];
                const LAS f32x4* fw = (const LAS f32x4*)(gs + 128 + 16 * ks + 8 * hi); const LAS f32x4* fb = (const LAS f32x4*)(gs + 64 + 16 * ks + 8 * hi);
                const f32x4 w0 = fw[0], w1 = fw[1], b0 = fb[0], b1 = fb[1];
                u32x4 p; p.x = cvtpk(a.x * w0.x, a.y * w0.y); p.y = cvtpk(a.z * w0.z, a.w * w0.w); p.z = cvtpk(c2.x * w1.x, c2.y * w1.y); p.w = cvtpk(c2.z * w1.z, c2.w * w1.w); Tfw[ct][ks] = __builtin_bit_cast(bf16x8, p);
                u32x4 q; q.x = cvtpk(a.x * b0.x, a.y * b0.y); q.y = cvtpk(a.z * b0.z, a.w * b0.w); q.z = cvtpk(c2.x * b1.x, c2.y * b1.y); q.w = cvtpk(c2.z * b1.z, c2.w * b1.w); Tfu[ct][ks] = __builtin_bit_cast(bf16x8, q); }
        wave_lds_fence();
        LAS bf16_t* Xs = (LAS bf16_t*)Nm;
#define D2_STAGE(SRC) do { _Pragma("unroll") for (int hb = 0; hb < 2; ++hb) { u32x4 sv[8]; \
            _Pragma("unroll") for (int i = 0; i < 8; ++i) sv[i] = *(const u32x4*)((SRC) + (size_t)(lane + 64 * (8 * hb + i)) * 8); \
            _Pragma("unroll") for (int i = 0; i < 8; ++i) *(LAS u32x4*)(Xs + (lane + 64 * (8 * hb + i)) * 8) = sv[i]; \
            __builtin_amdgcn_sched_barrier(0); } } while (0)
#define D2_XFRAG(dt, ks) ({ const LAS bf16_t* xp = Xs + (16 * (ks) + 8 * hi) * 128 + 32 * (dt) + r; \
            u32x4 pk_; pk_.x = (unsigned)xp[0] | ((unsigned)xp[128] << 16); pk_.y = (unsigned)xp[256] | ((unsigned)xp[384] << 16); \
            pk_.z = (unsigned)xp[512] | ((unsigned)xp[640] << 16); pk_.w = (unsigned)xp[768] | ((unsigned)xp[896] << 16); __builtin_bit_cast(bf16x8, pk_); })
        D2_STAGE(Kc);
        wave_lds_fence();
#pragma unroll 1
        for (int dt = 0; dt < 4; ++dt) {
            f32x16 wt0, wt1;
#pragma unroll
            for (int i = 0; i < 16; ++i) { wt0[i] = 0.f; wt1[i] = 0.f; }
#pragma unroll
            for (int ks = 0; ks < 4; ++ks) { const bf16x8 kfr = D2_XFRAG(dt, ks); wt0 = MFMA32(kfr, Tfw[0][ks], wt0); wt1 = MFMA32(kfr, Tfw[1][ks], wt1); }
            *(bf16x8*)(NWf + ((0 * 8 + 2 * dt) * 64 + lane) * 8) = pack8(wt0, 0); *(bf16x8*)(NWf + ((0 * 8 + 2 * dt + 1) * 64 + lane) * 8) = pack8(wt0, 1);
            *(bf16x8*)(NWf + ((1 * 8 + 2 * dt) * 64 + lane) * 8) = pack8(wt1, 0); *(bf16x8*)(NWf + ((1 * 8 + 2 * dt + 1) * 64 + lane) * 8) = pack8(wt1, 1);
        }
        __builtin_amdgcn_sched_barrier(0);
        {
            float k0[64], k1[64];
#pragma unroll
            for (int i = 0; i < 64; ++i) { const unsigned kv = *(const LAS unsigned*)(Xs + i * 128 + 2 * lane); const float f = __expf(gcl - gs[i]); k0[i] = bflo(kv) * f; k1[i] = bfhi(kv) * f; }
            const int j = lane >> 4, r0 = (2 * lane) & 31;
#pragma unroll
            for (int Gp = 0; Gp < 4; ++Gp)
#pragma unroll
                for (int hp = 0; hp < 2; ++hp) {
                    u32x4 o0, o1;
                    o0.x = cvtpk(k0[16 * Gp + 4 * hp + 0], k0[16 * Gp + 4 * hp + 1]); o0.y = cvtpk(k0[16 * Gp + 4 * hp + 2], k0[16 * Gp + 4 * hp + 3]);
                    o0.z = cvtpk(k0[16 * Gp + 4 * hp + 8], k0[16 * Gp + 4 * hp + 9]); o0.w = cvtpk(k0[16 * Gp + 4 * hp + 10], k0[16 * Gp + 4 * hp + 11]);
                    o1.x = cvtpk(k1[16 * Gp + 4 * hp + 0], k1[16 * Gp + 4 * hp + 1]); o1.y = cvtpk(k1[16 * Gp + 4 * hp + 2], k1[16 * Gp + 4 * hp + 3]);
                    o1.z = cvtpk(k1[16 * Gp + 4 * hp + 8], k1[16 * Gp + 4 * hp + 9]); o1.w = cvtpk(k1[16 * Gp + 4 * hp + 10], k1[16 * Gp + 4 * hp + 11]);
                    *(u32x4*)(KDf + (((j * 4 + Gp) * 64) + r0 + 32 * hp) * 8) = o0;
                    *(u32x4*)(KDf + (((j * 4 + Gp) * 64) + r0 + 1 + 32 * hp) * 8) = o1;
                }
        }
        __builtin_amdgcn_sched_barrier(0);
        wave_lds_fence();
        D2_STAGE(Vc);
        wave_lds_fence();
#pragma unroll 1
        for (int dt = 0; dt < 4; ++dt) {
            f32x16 u0, u1;
#pragma unroll
            for (int i = 0; i < 16; ++i) { u0[i] = 0.f; u1[i] = 0.f; }
#pragma unroll
            for (int ks = 0; ks < 4; ++ks) { const bf16x8 vfr = D2_XFRAG(dt, ks); u0 = MFMA32(Tfu[0][ks], vfr, u0); u1 = MFMA32(Tfu[1][ks], vfr, u1); }
            *(bf16x8*)(UF + ((dt * 2 + 0) * 64 + lane) * 16) = pack8(u0, 0); *(bf16x8*)(UF + ((dt * 2 + 0) * 64 + lane) * 16 + 8) = pack8(u0, 1);
            *(bf16x8*)(UF + ((dt * 2 + 1) * 64 + lane) * 16) = pack8(u1, 0); *(bf16x8*)(UF + ((dt * 2 + 1) * 64 + lane) * 16 + 8) = pack8(u1, 1);
        }
#undef D2_STAGE
#undef D2_XFRAG
        wave_lds_fence();
    }
    __builtin_amdgcn_sched_barrier(0); asm volatile("" ::: "memory");
#pragma unroll
    for (int t = 0; t < 2; ++t) { const float f = __expf(gs[32 * t + r]); const bf16_t* qrow = Qc + (32 * t + r) * 128 + 4 * hi;
#pragma unroll
        for (int G = 0; G < 8; ++G) { const u32x2 a = *(const u32x2*)(qrow + 16 * G), c2 = *(const u32x2*)(qrow + 16 * G + 8);
            u32x4 o; o.x = cvtpk(bflo(a.x) * f, bfhi(a.x) * f); o.y = cvtpk(bflo(a.y) * f, bfhi(a.y) * f); o.z = cvtpk(bflo(c2.x) * f, bfhi(c2.x) * f); o.w = cvtpk(bflo(c2.y) * f, bfhi(c2.y) * f);
            *(u32x4*)(QGf + ((t * 8 + G) * 64 + lane) * 8) = o; } }
    __builtin_amdgcn_sched_barrier(0); asm volatile("" ::: "memory");
    if (lane == 0) ((float*)(P.ws + WS_GL))[chunk] = __expf(gcl);
    wave_lds_fence();
}

#define D3_LD(BASE, OFF) (*(const u32x4*)((BASE) + (OFF) + (size_t)voff))
#define D3_ISSUE(V, CH) do { const size_t ch_ = (size_t)(CH); const unsigned voff = (unsigned)ltid * 16u; \
        const char* s0 = (const char*)P.ws + WS_NW + ch_ * 16384; const char* s1 = (const char*)P.ws + WS_QG + ch_ * 16384; \
        const char* s2 = (const char*)P.ws + WS_IN + ch_ * 8192; const char* s3 = (const char*)P.ws + WS_KD + ch_ * 16384; const char* s4 = (const char*)P.ws + WS_UF + ch_ * 16384 + (size_t)vs * 4096; \
        _Pragma("unroll") for (int i = 0; i < 4; ++i) { V[i] = D3_LD(s0, 4096 * i); V[4 + i] = D3_LD(s1, 4096 * i); V[10 + i] = D3_LD(s3, 4096 * i); } \
        V[8] = D3_LD(s2, 0); V[9] = D3_LD(s2, 4096); V[14] = D3_LD(s4, 0); } while (0)
#define D3_WRITE(V, SLOT) do { LAS u32x4* d = (LAS u32x4*)(SLOT) + ltid; \
        _Pragma("unroll") for (int i = 0; i < 4; ++i) { d[256 * i] = V[i]; d[1024 + 256 * i] = V[4 + i]; d[2560 + 256 * i] = V[10 + i]; } \
        d[2048] = V[8]; d[2048 + 256] = V[9]; d[3584] = V[14]; } while (0)
#define D3_BAR() do { asm volatile("s_waitcnt lgkmcnt(0)" ::: "memory"); __builtin_amdgcn_s_barrier(); asm volatile("" ::: "memory"); } while (0)
constexpr int D3_EXSB = 2 * D3_SLOT, D3_EXVB = D3_EXSB + 8192;
DI void d3_block(const Params& P, int bh, int vs, LAS unsigned char* lds, int wave, int lane, int tid) {
    const int b = bh >> 3, h = bh & 7, r = lane & 31, hi = lane >> 5, ltid = tid - 256, ch0 = bh * 128;
    const float* GL = (const float*)(P.ws + WS_GL) + ch0;
    float* ODN = (float*)(P.ws + WS_ODN);
    LAS bf16x8* exSb = (LAS bf16x8*)(lds + D3_EXSB) + lane; LAS bf16x8* exVb = (LAS bf16x8*)(lds + D3_EXVB) + lane;
    LAS float* ostage0 = (LAS float*)(lds + D3_EXVB + 4096);
    volatile LAS unsigned* vflag = (volatile LAS unsigned*)(lds + D3_EXVB + 4096 + 2 * 9216);
    if (wave >= 4) {
        u32x4 VA[15], VB[15], VC[15];
        D3_ISSUE(VA, ch0); D3_ISSUE(VB, ch0 + 1); D3_ISSUE(VC, ch0 + 2); D3_WRITE(VA, lds); D3_ISSUE(VA, ch0 + 3);
        D3_BAR();
#define D3_LSTEP(N, VNEXT) do { const int n_ = (N); const int nx_ = (n_ + 4 < 127) ? n_ + 4 : 127; \
            D3_WRITE(VNEXT, lds + ((n_ + 1) & 1) * D3_SLOT); D3_ISSUE(VNEXT, ch0 + nx_); \
            D3_BAR(); } while (0)
#pragma unroll 1
        for (int n0 = 0; n0 < 126; n0 += 3) { D3_LSTEP(n0, VB); D3_LSTEP(n0 + 1, VC); D3_LSTEP(n0 + 2, VA); }
        D3_LSTEP(126, VB);
        D3_BAR();
        asm volatile("s_waitcnt vmcnt(0)" ::: "memory");
#undef D3_LSTEP
    } else if (wave == 0) {
        f32x16 S[4]; bf16x8 Sb[8];
#pragma unroll
        for (int j = 0; j < 4; ++j)
#pragma unroll
            for (int i = 0; i < 16; ++i) S[j][i] = 0.f;
#pragma unroll
        for (int G = 0; G < 8; ++G) { Sb[G] = (bf16x8){0, 0, 0, 0, 0, 0, 0, 0}; exSb[G * 64] = Sb[G]; }
        if (lane == 0) *vflag = 0u;
        D3_BAR();
        float gl = GL[0];
#pragma unroll 1
        for (int n = 0; n < 128; ++n) {
            const LAS unsigned char* sb = lds + (n & 1) * D3_SLOT;
            const LAS bf16x8* fNW = (const LAS bf16x8*)sb + lane; const LAS bf16x8* fKD = (const LAS bf16x8*)(sb + 40960) + lane;
            const LAS u32x4* fU = (const LAS u32x4*)(sb + 57344) + lane * 2;
            const float gl_next = GL[(n + 1) & 127];
            bf16x8 fw[16];
#pragma unroll
            for (int q = 0; q < 16; ++q) fw[q] = fNW[q * 64];
            f32x16 vt[2];
#pragma unroll
            for (int t = 0; t < 2; ++t) { const u32x4 a = fU[t * 128], b2 = fU[t * 128 + 1];
                vt[t][0] = bflo(a.x); vt[t][1] = bfhi(a.x); vt[t][2] = bflo(a.y); vt[t][3] = bfhi(a.y); vt[t][4] = bflo(a.z); vt[t][5] = bfhi(a.z); vt[t][6] = bflo(a.w); vt[t][7] = bfhi(a.w);
                vt[t][8] = bflo(b2.x); vt[t][9] = bfhi(b2.x); vt[t][10] = bflo(b2.y); vt[t][11] = bfhi(b2.y); vt[t][12] = bflo(b2.z); vt[t][13] = bfhi(b2.z); vt[t][14] = bflo(b2.w); vt[t][15] = bfhi(b2.w); }
            __builtin_amdgcn_sched_barrier(0);
#pragma unroll
            for (int G = 0; G < 8; ++G) {
                vt[0] = MFMA32(fw[G], Sb[G], vt[0]); vt[1] = MFMA32(fw[8 + G], Sb[G], vt[1]);
                if (G < 4) {
#pragma unroll
                    for (int i = 0; i < 16; ++i) S[G][i] *= gl; } }
            __builtin_amdgcn_sched_barrier(0);
            bf16x8 fk[16];
#pragma unroll
            for (int q = 0; q < 16; ++q) fk[q] = fKD[q * 64];
            __builtin_amdgcn_sched_barrier(0);
            bf16x8 Vb[4];
            Vb[0] = pack8(vt[0], 0); Vb[1] = pack8(vt[0], 1); Vb[2] = pack8(vt[1], 0); Vb[3] = pack8(vt[1], 1);
#pragma unroll
            for (int G = 0; G < 4; ++G) exVb[G * 64] = Vb[G];
            asm volatile("s_waitcnt lgkmcnt(0)" ::: "memory");
            if (lane == 0) *vflag = (unsigned)(n + 1);
#pragma unroll
            for (int G = 0; G < 4; ++G) { S[0] = MFMA32(fk[G], Vb[G], S[0]); S[1] = MFMA32(fk[4 + G], Vb[G], S[1]); S[2] = MFMA32(fk[8 + G], Vb[G], S[2]); S[3] = MFMA32(fk[12 + G], Vb[G], S[3]); }
            __builtin_amdgcn_sched_barrier(0);
#pragma unroll
            for (int j = 0; j < 4; ++j) { Sb[2 * j] = pack8(S[j], 0); Sb[2 * j + 1] = pack8(S[j], 1); exSb[(2 * j) * 64] = Sb[2 * j]; exSb[(2 * j + 1) * 64] = Sb[2 * j + 1]; }
            gl = gl_next;
            D3_BAR();
        }
    } else if (wave == 1) {
        D3_BAR();
#pragma unroll 1
        for (int n = 0; n < 128; ++n) {
            const LAS unsigned char* sb = lds + (n & 1) * D3_SLOT;
            const LAS bf16x8* fQG = (const LAS bf16x8*)(sb + 16384) + lane; const LAS bf16x8* fIN = (const LAS bf16x8*)(sb + 32768) + lane;
            bf16x8 Sb[8], fq[16];
#pragma unroll
            for (int G = 0; G < 8; ++G) Sb[G] = exSb[G * 64];
#pragma unroll
            for (int q = 0; q < 16; ++q) fq[q] = fQG[q * 64];
            f32x16 ot[2];
#pragma unroll
            for (int i = 0; i < 16; ++i) { ot[0][i] = 0.f; ot[1][i] = 0.f; }
            __builtin_amdgcn_sched_barrier(0);
#pragma unroll
            for (int G = 0; G < 8; ++G) { ot[0] = MFMA32(fq[G], Sb[G], ot[0]); ot[1] = MFMA32(fq[8 + G], Sb[G], ot[1]); }
            __builtin_amdgcn_sched_barrier(0);
            bf16x8 fi[8];
#pragma unroll
            for (int q = 0; q < 8; ++q) fi[q] = fIN[q * 64];
            { unsigned spins = 0; while (*vflag < (unsigned)(n + 1) && ++spins < (1u << 22)) __builtin_amdgcn_s_sleep(1); }
            asm volatile("" ::: "memory");
            bf16x8 Vb[4];
#pragma unroll
            for (int G = 0; G < 4; ++G) Vb[G] = exVb[G * 64];
#pragma unroll
            for (int G = 0; G < 4; ++G) { ot[0] = MFMA32(fi[G], Vb[G], ot[0]); ot[1] = MFMA32(fi[4 + G], Vb[G], ot[1]); }
#pragma unroll
            for (int t = 0; t < 2; ++t)
#pragma unroll
                for (int i = 0; i < 16; ++i) (ostage0 + (n & 1) * 2304)[(32 * t + (i & 3) + 8 * (i >> 2) + 4 * hi) * 36 + r] = ot[t][i];
            D3_BAR();
        }
    } else {
        const int row0 = 32 * (wave - 2) + (lane >> 3), col4 = 4 * (lane & 7);
        float* orow = ODN + (size_t)(b * T + row0) * 1024 + h * 128 + vs * 32 + col4;
        D3_BAR();
#pragma unroll 1
        for (int n = 0; n <= 128; ++n) {
            if (n > 0) {
#pragma unroll
                for (int j = 0; j < 4; ++j) { const f32x4 v = *(const LAS f32x4*)(ostage0 + ((n - 1) & 1) * 2304 + (row0 + 8 * j) * 36 + col4); *(f32x4*)(orow + (size_t)((n - 1) * 64 + 8 * j) * 1024) = v; } }
            if (n < 128) D3_BAR();
        }
    }
}
#undef D3_ISSUE
#undef D3_WRITE
#undef D3_BAR
#undef D3_LD

DI void att_unit(const Params& P, int l, int unit, LAS unsigned char* lds, int wave, int lane, int tid) {
    const int qblk = unit & 63, kvh = (unit >> 6) & 1, b = unit >> 7, r = lane & 31, hi = lane >> 5;
    const bf16_t* PROJ = (const bf16_t*)(P.ws + WS_PROJ); bf16_t* MIX = (bf16_t*)(P.ws + WS_ACT);
    LAS bf16_t* Ks = (LAS bf16_t*)lds;
    LAS bf16_t* Vt = (LAS bf16_t*)(lds + 36864);
    const int kpos0 = (qblk - 1) * 128;
#pragma unroll
    for (int i = 0; i < 4; ++i) { const int p = tid + 512 * i, key = p >> 3, dp = p & 7; const int kp = kpos0 + key;
        u32x4 kv = {0u, 0u, 0u, 0u}, vv = {0u, 0u, 0u, 0u};
        if (kp >= 0) { const bf16_t* src = PROJ + (size_t)(b * T + kp) * NPROJ; kv = *(const u32x4*)(src + C_K + kvh * 64 + 8 * dp); vv = *(const u32x4*)(src + C_V + kvh * 64 + 8 * dp); }
        *(LAS u32x4*)(Ks + key * 72 + 8 * dp) = kv;
        const int pk = swap23(key); LAS bf16_t* vd = Vt + (8 * dp) * 264 + pk;
        vd[0 * 264] = (bf16_t)(vv.x & 0xffffu); vd[1 * 264] = (bf16_t)(vv.x >> 16); vd[2 * 264] = (bf16_t)(vv.y & 0xffffu); vd[3 * 264] = (bf16_t)(vv.y >> 16);
        vd[4 * 264] = (bf16_t)(vv.z & 0xffffu); vd[5 * 264] = (bf16_t)(vv.z >> 16); vd[6 * 264] = (bf16_t)(vv.w & 0xffffu); vd[7 * 264] = (bf16_t)(vv.w >> 16); }
    __syncthreads();
    const int qh = kvh * 8 + wave; const float sink = P.sinks[l * 16 + qh];
    for (int qt = 0; qt < 4; ++qt) {
        const int mrow = b * T + qblk * 128 + 32 * qt + r;
        bf16x8 qf[4];
#pragma unroll
        for (int kk = 0; kk < 4; ++kk) qf[kk] = *(const bf16x8*)(PROJ + (size_t)mrow * NPROJ + C_Q + qh * 64 + 16 * kk + 8 * hi);
        f32x16 st[5];
        const int rq = 32 * qt + r; float mx = -INFINITY;
        const int jlo = (qblk > 0 || rq + 1 >= 128) ? rq + 1 : 128; const unsigned jspan = (unsigned)(rq + 128 - jlo);
#pragma unroll
        for (int i = 0; i < 5; ++i) { const int kt = qt + i;
#pragma unroll
            for (int e = 0; e < 16; ++e) st[i][e] = 0.f;
#pragma unroll
            for (int kk = 0; kk < 4; ++kk) st[i] = MFMA32(*(const LAS bf16x8*)(Ks + (32 * kt + r) * 72 + 16 * kk + 8 * hi), qf[kk], st[i]);
#pragma unroll
            for (int e = 0; e < 16; ++e) { const int j = 32 * kt + crow(e, hi); const bool valid = (unsigned)(j - jlo) <= jspan;
                st[i][e] = valid ? st[i][e] : -INFINITY; mx = fmaxf(mx, st[i][e]); }
            __builtin_amdgcn_sched_barrier(0); }
        mx = fmaxf(mx, __shfl_xor(mx, 32)); mx = fmaxf(mx, sink);
        float sum = 0.f;
#pragma unroll
        for (int i = 0; i < 5; ++i)
#pragma unroll
            for (int e = 0; e < 16; ++e) { const float p = __expf(st[i][e] - mx); st[i][e] = p; sum += p; }
        sum += __shfl_xor(sum, 32);
        const float inv = 1.0f / (sum + __expf(sink - mx));
        f32x16 ot[2];
#pragma unroll
        for (int e = 0; e < 16; ++e) { ot[0][e] = 0.f; ot[1][e] = 0.f; }
#pragma unroll
        for (int i = 0; i < 5; ++i) { const int kt = qt + i;
#pragma unroll
            for (int g = 0; g < 2; ++g) { const bf16x8 pb = pack8(st[i], g);
                ot[0] = MFMA32(*(const LAS bf16x8*)(Vt + (r) * 264 + 16 * (2 * kt + g) + 8 * hi), pb, ot[0]);
                ot[1] = MFMA32(*(const LAS bf16x8*)(Vt + (32 + r) * 264 + 16 * (2 * kt + g) + 8 * hi), pb, ot[1]); } }
        bf16_t* op = MIX + (size_t)mrow * D + 1024 + qh * 64;
#pragma unroll
        for (int dt = 0; dt < 2; ++dt)
#pragma unroll
            for (int a = 0; a < 4; ++a) { u32x2 w; w.x = cvtpk(ot[dt][4 * a] * inv, ot[dt][4 * a + 1] * inv); w.y = cvtpk(ot[dt][4 * a + 2] * inv, ot[dt][4 * a + 3] * inv);
                *(u32x2*)(op + 32 * dt + 8 * a + 4 * hi) = w; }
    }
    __syncthreads();
}

DI void d4_phase(const Params& P, int l, int gw, int NGW, int lane) {
    const float* ODN = (const float*)(P.ws + WS_ODN); const bf16_t* PROJ = (const bf16_t*)(P.ws + WS_PROJ); bf16_t* MIX = (bf16_t*)(P.ws + WS_ACT);
    const int d0 = (lane & 7) * 16; const float* nw = P.norm_w + l * 128 + d0;
    f32x4 g[4];
#pragma unroll
    for (int j = 0; j < 4; ++j) g[j] = *(const f32x4*)(nw + 4 * j);
    typedef __attribute__((address_space(1))) const f32x4* gcf; typedef __attribute__((address_space(1))) const u32x4* gcu;
    for (int mb = gw; mb < M; mb += 4 * NGW) {
        f32x4 vv[4][4]; u32x4 zz[4][2];
#pragma unroll
        for (int q = 0; q < 4; ++q) { const int m = mb + q * NGW; if (m < M) {
#pragma unroll
            for (int j = 0; j < 4; ++j) vv[q][j] = ((gcf)(ODN + (size_t)m * 1024 + lane * 16))[j];
            zz[q][0] = *(gcu)(PROJ + (size_t)m * NPROJ + C_Z + lane * 16); zz[q][1] = *(gcu)(PROJ + (size_t)m * NPROJ + C_Z + lane * 16 + 8); } }
#pragma unroll
        for (int q = 0; q < 4; ++q) { const int m = mb + q * NGW; if (m < M) {
            float ss = 0.f;
#pragma unroll
            for (int j = 0; j < 4; ++j) ss += (vv[q][j].x * vv[q][j].x + vv[q][j].y * vv[q][j].y) + (vv[q][j].z * vv[q][j].z + vv[q][j].w * vv[q][j].w);
            ss += __shfl_xor(ss, 1); ss += __shfl_xor(ss, 2); ss += __shfl_xor(ss, 4);
            const float rstd = __builtin_amdgcn_rsqf(ss * (1.0f / 128.f) + EPS);
            const u32x4 z0 = zz[q][0], z1 = zz[q][1];
            const float zf[16] = {bflo(z0.x), bfhi(z0.x), bflo(z0.y), bfhi(z0.y), bflo(z0.z), bfhi(z0.z), bflo(z0.w), bfhi(z0.w), bflo(z1.x), bfhi(z1.x), bflo(z1.y), bfhi(z1.y), bflo(z1.z), bfhi(z1.z), bflo(z1.w), bfhi(z1.w)};
            float y[16];
#pragma unroll
            for (int j = 0; j < 4; ++j) { y[4 * j] = vv[q][j].x * rstd * g[j].x * silu(zf[4 * j]); y[4 * j + 1] = vv[q][j].y * rstd * g[j].y * silu(zf[4 * j + 1]);
                y[4 * j + 2] = vv[q][j].z * rstd * g[j].z * silu(zf[4 * j + 2]); y[4 * j + 3] = vv[q][j].w * rstd * g[j].w * silu(zf[4 * j + 3]); }
            u32x4 w0, w1; w0.x = cvtpk(y[0], y[1]); w0.y = cvtpk(y[2], y[3]); w0.z = cvtpk(y[4], y[5]); w0.w = cvtpk(y[6], y[7]); w1.x = cvtpk(y[8], y[9]); w1.y = cvtpk(y[10], y[11]); w1.z = cvtpk(y[12], y[13]); w1.w = cvtpk(y[14], y[15]);
            *(u32x4*)(MIX + (size_t)m * D + lane * 16) = w0; *(u32x4*)(MIX + (size_t)m * D + lane * 16 + 8) = w1; } }
    }
}

#define XB_TMO      128
#define XB_XCNT(j)  (256  + 64 * (j))
#define XB_XSUB(j)  (1280 + 64 * (j))
#define XB_XGEN(j)  (2304 + 64 * (j))
#define XB_TOP      3328
#define XB_TOPGEN   3392
#define XCD_BAR_WORDS 3456
#define XB_SPIN_CAP (1u << 18)

__device__ __forceinline__ unsigned xb_ld(unsigned* p)              { return __hip_atomic_load(p, __ATOMIC_RELAXED, __HIP_MEMORY_SCOPE_AGENT); }
__device__ __forceinline__ unsigned xb_add(unsigned* p, unsigned v) { return __hip_atomic_fetch_add(p, v, __ATOMIC_RELAXED, __HIP_MEMORY_SCOPE_AGENT); }
__device__ __forceinline__ unsigned xb_xcc_id() { return (unsigned)__builtin_amdgcn_s_getreg((3 << 11) | 20) & 0xFu; }
#define XB_SPIN(cond, bar) do { unsigned _sp = 0; while (cond) { __builtin_amdgcn_s_sleep(1); \
    if ((++_sp & 255u) == 0u) { if (xb_ld(&(bar)[XB_TMO])) break; if (_sp > XB_SPIN_CAP) { atomicAdd(&(bar)[XB_TMO], 1u); break; } } } } while (0)

struct XcdBarrier {
    unsigned* bar; unsigned x;
    volatile LAS unsigned* st;
};

__device__ __forceinline__ XcdBarrier xcd_barrier_post(unsigned* bar, volatile LAS unsigned* st) {
    XcdBarrier b; b.bar = bar; b.x = xb_xcc_id(); b.st = st;
    if (threadIdx.x == 0) (void)xb_add(&bar[XB_XCNT(b.x)], 1u);
    return b;
}
__device__ __forceinline__ void xcd_barrier_complete(unsigned* bar, unsigned x, unsigned& nloc, unsigned& nx) {
    const unsigned G = gridDim.x * gridDim.y * gridDim.z;
    unsigned sum, cnt, mine, sp = 0u;
    for (;;) {
        sum = 0u; cnt = 0u; mine = 0u;
#pragma unroll
        for (unsigned j = 0; j < 16; ++j) { const unsigned c = xb_ld(&bar[XB_XCNT(j)]); sum += c; cnt += (c > 0u) ? 1u : 0u; mine = (j == x) ? c : mine; }
        if (sum == G) break;
        __builtin_amdgcn_s_sleep(1);
        if ((++sp & 255u) == 0u) { if (xb_ld(&bar[XB_TMO])) break; if (sp > XB_SPIN_CAP) { atomicAdd(&bar[XB_TMO], 1u); break; } }
    }
    nloc = mine > 0u ? mine : 1u; nx = cnt > 0u ? cnt : 1u;
}

__device__ __forceinline__ void xcd_barrier(const XcdBarrier& b) {
    asm volatile("s_waitcnt vmcnt(0)" ::: "memory");
    __syncthreads();
    if (threadIdx.x == 0) {
        unsigned* bar = b.bar;
        __builtin_amdgcn_s_waitcnt(0);
        unsigned nloc = b.st[0], nx = b.st[1];
        if (nloc == 0u) { xcd_barrier_complete(bar, b.x, nloc, nx); b.st[0] = nloc; b.st[1] = nx; }
        const unsigned old = xb_add(&bar[XB_XSUB(b.x)], 1u);
        const unsigned gen = old / nloc;
        if (old + 1u == (gen + 1u) * nloc) {
            __builtin_amdgcn_fence(__ATOMIC_RELEASE, "agent");
            asm volatile("s_waitcnt vmcnt(0)" ::: "memory");
            const unsigned og = xb_add(&bar[XB_TOP], 1u);
            const unsigned tg = og / nx;
            if (og + 1u == (tg + 1u) * nx) xb_add(&bar[XB_TOPGEN], 1u);
            else XB_SPIN(xb_ld(&bar[XB_TOPGEN]) == tg, bar);
            __builtin_amdgcn_fence(__ATOMIC_ACQUIRE, "agent");
            xb_add(&bar[XB_XGEN(b.x)], 1u);
            asm volatile("s_waitcnt vmcnt(0)" ::: "memory");
        } else {
            XB_SPIN(xb_ld(&bar[XB_XGEN(b.x)]) == gen, bar);
            __builtin_amdgcn_fence(__ATOMIC_ACQUIRE, "agent");
            asm volatile("s_waitcnt vmcnt(0)" ::: "memory");
        }
    }
    __syncthreads();
}

constexpr int N_PHASES = 23;
#ifndef USE_XCD_BARRIER
#define USE_XCD_BARRIER 1
#endif
#ifndef PHASE_MASK
#define PHASE_MASK 0xffff
#endif
#define EN(k) if constexpr (((PHASE_MASK) >> (k)) & 1)
__global__ void __launch_bounds__(512, 2) fwd_kernel(Params PK) {
    extern __shared__ __attribute__((aligned(16))) unsigned char lds_raw[];
    LAS unsigned char* lds = (LAS unsigned char*)lds_raw;
    cg::grid_group grid = cg::this_grid();
    volatile LAS unsigned* bst = (volatile LAS unsigned*)(lds + LDS_BYTES - 64);
    if (threadIdx.x < 2) bst[threadIdx.x] = 0u;
    __syncthreads();
    const XcdBarrier xbar = xcd_barrier_post((unsigned*)(PK.ws + WS_CTL), bst);
    const int G = gridDim.x, NGW = G * 8;
#ifndef DOUBLE_MASK
#define DOUBLE_MASK 0
#endif
#ifndef DOUBLE_PH_END
#define DOUBLE_PH_END 22
#endif
#ifndef DOUBLE_P0
#define DOUBLE_P0 0
#endif
    for (int it = 0, ph = PK.ph_lo, rep = 0; ph < PK.ph_hi; ++it, ((rep == 0 && ((ph >= 2 && ph < DOUBLE_PH_END && ((DOUBLE_MASK >> ((ph - 2) % 10)) & 1)) || (DOUBLE_P0 && ph == 0))) ? (rep = 1) : (rep = 0, ++ph))) {
        if (!USE_XCD_BARRIER || PK.ph_lo > 1000) { if (it > 0) grid.sync(); } else if (it > 0) xcd_barrier(xbar);
        Params P = PK;
        { typedef __attribute__((address_space(1))) unsigned char* gptr; typedef __attribute__((address_space(1))) float* gfp; typedef __attribute__((address_space(1))) const float* gcfp;
          gptr gws = (gptr)PK.ws; gfp gout = (gfp)PK.out; gcfp gx = (gcfp)PK.x; asm volatile("" : "+s"(gws), "+s"(gout), "+s"(gx));
          P.ws = (unsigned char*)gws; P.out = (float*)gout; P.x = (const float*)gx; }
        int tid = threadIdx.x; asm volatile("" : "+v"(tid));
        const int lane = tid & 63, wave = __builtin_amdgcn_readfirstlane(tid >> 6), gw = blockIdx.x * 8 + wave;
        bf16_t* ACT = (bf16_t*)(P.ws + WS_ACT); bf16_t* PROJ = (bf16_t*)(P.ws + WS_PROJ);
        const float* MOD = (const float*)(P.ws + WS_MOD);
        if (ph == 0) { EN(10) p0_phase(P, lds, gw, NGW, wave, lane); continue; }
        if (ph == 1) { EN(11) mod_phase(P, gw, NGW, lane); continue; }
        bf16_t* YB = (bf16_t*)(P.ws + WS_QN);
        bf16_t* XR = (bf16_t*)(P.ws + WS_XR);
        if (ph == 22) { EN(12) norm_phase<1, true>(XR, YB, nullptr, P.out, P.ln_final, nullptr, 0, 0, nullptr, gw, NGW, lane); continue; }
        const int l = (ph - 2) / 10, sp = (ph - 2) % 10;
        const float* modl = MOD + (size_t)l * 2 * NMOD;
        const float* xin = (l == 0) ? P.x : P.out;
        switch (sp) {
        case 0: EN(0) { if (l == 0) norm_phase<0, false>(P.x, nullptr, nullptr, nullptr, P.ln_mix, modl, 0, 2048, ACT, gw, NGW, lane);
                        else norm_phase<0, true>(XR, YB, XR, nullptr, P.ln_mix + l * D, modl, 0, 2048, ACT, gw, NGW, lane); } break;
        case 1: EN(1) { pg8::Gemm g{ACT, (const bf16_t*)(P.ws + WS_WIN) + (size_t)l * NPROJ * D, M, NPROJ, D}; pg8::StaticOrder S; S.init(M, NPROJ, G, (int)blockIdx.x);
            EpiIn E{PROJ, (float*)(P.ws + WS_BA), (const float*)(P.ws + WS_ROPE)};
            pg8::gemm_phase<EpiIn, pg8::StaticOrder, true, true>(lds, g, S, E, tid); } break;
        case 2: EN(2) d1_phase(P, l, gw, NGW, lane); break;
        case 3: EN(3) { LAS float* Nm = (LAS float*)(lds + wave * (64 * NMS * 4)); LAS float* gs = (LAS float*)(lds + 8 * (64 * NMS * 4) + wave * 1024);
            for (int ch = gw; ch < 2048; ch += NGW) d2_chunk(P, l, ch, Nm, gs, lane); } break;
#ifndef DOUBLE_SUB
#define DOUBLE_SUB 3
#endif
        case 4: if ((int)blockIdx.x < 64) { if (rep == 0 || (DOUBLE_SUB & 1)) { const int bx = (int)blockIdx.x, xq = bx >> 3;
                        EN(4) d3_block(P, 2 * (bx & 7) + (xq >> 2), xq & 3, lds, wave, lane, tid); } }
                else if (rep == 0 || (DOUBLE_SUB & 2)) { EN(13) for (int u = (int)blockIdx.x - 64; u < 256; u += G - 64) att_unit(P, l, u, lds, wave, lane, tid);
                    if (rep == 0) { EN(10) convert_items(P, lds, l == 0 ? I_IN : I_L + I_IN, l == 0 ? I_L + I_IN : 2 * I_L, ((int)blockIdx.x - 64) * 8 + wave, (G - 64) * 8, wave, lane); } }
                break;
        case 5: EN(5) d4_phase(P, l, gw, NGW, lane); break;
        case 6: EN(6) { pg8::Gemm g{ACT, (const bf16_t*)(P.ws + WS_WOUT) + (size_t)l * D * D, M, D, D}; pg8::StaticOrder S; S.init(M, D, G, (int)blockIdx.x);
            EpiY E{YB, modl + 4096};
            pg8::gemm_phase<EpiY, pg8::StaticOrder, true, true>(lds, g, S, E, tid); } break;
        case 7: EN(7) { if (l == 0) norm_phase<0, false>(P.x, YB, XR, nullptr, P.ln_ffn, modl, 6144, 8192, ACT, gw, NGW, lane);
                        else norm_phase<0, true>(XR, YB, XR, nullptr, P.ln_ffn + l * D, modl, 6144, 8192, ACT, gw, NGW, lane); } break;
        case 8: EN(8) { pg8::Gemm g{ACT, (const bf16_t*)(P.ws + WS_WGU) + (size_t)l * NGU * D, M, NGU, D}; pg8::StaticOrder S; S.init(M, NGU, G, (int)blockIdx.x);
            EpiSwiglu E{PROJ};
            pg8::gemm_phase<EpiSwiglu, pg8::StaticOrder, true, true>(lds, g, S, E, tid); } break;
        case 9: EN(9) { pg8::Gemm g{PROJ, (const bf16_t*)(P.ws + WS_WDN) + (size_t)l * D * FF, M, D, FF}; pg8::StaticOrder S; S.init(M, D, G, (int)blockIdx.x);
            EpiY E{YB, modl + 10240};
            pg8::gemm_phase<EpiY, pg8::StaticOrder, true, true>(lds, g, S, E, tid); } break;
        }
    }
}
}

extern "C" void kernel_launch(void* const* d_in, const int* in_sizes, int n_in, void* d_out, int out_size, void* d_ws, size_t ws_size, hipStream_t stream) {
    static int grid = 0;
    if (grid == 0) {
        if (n_in != 16 || out_size != mk::M * mk::D || ws_size < mk::WS_END) { fprintf(stderr, "kernel_launch: unexpected shapes (n_in %d, out %d, ws %zu)\n", n_in, out_size, ws_size); grid = -1; return; }
        int dev = 0, cus = 0, per_cu = 0;
        hipGetDevice(&dev); hipDeviceGetAttribute(&cus, hipDeviceAttributeMultiprocessorCount, dev);
        if (hipFuncSetAttribute((const void*)mk::fwd_kernel, hipFuncAttributeMaxDynamicSharedMemorySize, mk::LDS_BYTES) != hipSuccess) { fprintf(stderr, "kernel_launch: hipFuncSetAttribute failed\n"); grid = -1; return; }
        if (hipOccupancyMaxActiveBlocksPerMultiprocessor(&per_cu, (const void*)mk::fwd_kernel, 512, mk::LDS_BYTES) != hipSuccess || per_cu < 1) per_cu = 1;
        (void)hipGetLastError();
        grid = cus * per_cu;
        if (grid < 128) { fprintf(stderr, "kernel_launch: grid %d too small\n", grid); grid = -1; return; }
    }
    if (grid < 0) return;
    mk::Params p{};
    const float** f = (const float**)&p;
    for (int i = 0; i < 16; ++i) f[i] = (const float*)d_in[i];
    p.out = (float*)d_out; p.ws = (unsigned char*)d_ws;
#if ONE_LAUNCH
    p.ph_lo = 0; p.ph_hi = mk::N_PHASES;
    if (hipMemsetAsync((char*)d_ws + mk::WS_CTL, 0, 65536, stream) != hipSuccess) { fprintf(stderr, "kernel_launch: memset of the barrier words failed\n"); return; }
    void* args[] = {&p};
    hipError_t e = hipLaunchCooperativeKernel((const void*)mk::fwd_kernel, dim3(grid), dim3(512), args, mk::LDS_BYTES, stream);
    if (e != hipSuccess) fprintf(stderr, "cooperative launch failed: %s (grid %d)\n", hipGetErrorString(e), grid);
#else
    for (int ph = 0; ph < mk::N_PHASES; ++ph) { p.ph_lo = ph; p.ph_hi = ph + 1; hipLaunchKernelGGL(mk::fwd_kernel, dim3(grid), dim3(512), mk::LDS_BYTES, stream, p); }
#endif
}
```
